# Optimizing an MI355X kernel written in HIP

```python
import math
import jax, jax.numpy as jnp
from jax import lax
import numpy as np

D_MODEL = 1024
BATCH = 32
SEQ = 2048
DEPTH = 1

HEAD_DIM = 64
N_ATTN_HEADS = 12
ATTN_WIDTH = N_ATTN_HEADS * HEAD_DIM
CONV_WIDTH = D_MODEL - ATTN_WIDTH
CONV_GROUPS = 4
CONV_K = 3
PROJ_WIDTH = 3 * ATTN_WIDTH + 3 * CONV_WIDTH
SPLIT_POINTS = [ATTN_WIDTH, 2 * ATTN_WIDTH, 3 * ATTN_WIDTH,
                3 * ATTN_WIDTH + CONV_WIDTH, 3 * ATTN_WIDTH + 2 * CONV_WIDTH]

DILATED_BRANCHES = ((128, 1), (512, 4), (2048, 16))
ATTN_BLOCK = 128
N_REL_BUCKETS = 32
REL_MAX_DISTANCE = 2048

N_EXPERTS = 256
TOP_K = 8
N_EXPERT_GROUPS = 8
TOPK_GROUPS = 4
EXPERT_DIM = 256
SHARED_DIM = 256
ROUTED_SCALE = 2.5
MOE_BLOCK = 128

DEEPNORM_ALPHA = (2.0 * DEPTH) ** 0.25
DEEPNORM_BETA = (8.0 * DEPTH) ** -0.25
LN_EPS = 1e-5

kernel_name = "hymba_dilated_conv_moe_deepnorm"


def _layer_norm(x, g, b):
    xf = x.astype(jnp.float32)
    mu = xf.mean(-1, keepdims=True)
    var = jnp.square(xf - mu).mean(-1, keepdims=True)
    return ((xf - mu) * lax.rsqrt(var + LN_EPS) * g + b).astype(x.dtype)


def _t5_bucket(dist):
    max_exact = N_REL_BUCKETS // 2
    dist = np.asarray(dist)
    log_part = np.log(np.maximum(dist, 1) / max_exact) / math.log(REL_MAX_DISTANCE / max_exact)
    large = max_exact + (log_part * (N_REL_BUCKETS - max_exact)).astype(np.int32)
    large = np.minimum(large, N_REL_BUCKETS - 1)
    return np.where(dist < max_exact, dist, large).astype(np.int32)


def _branch_pattern(window, dilation, n_blocks):
    w_sub = window // dilation
    assert w_sub <= ATTN_BLOCK
    qi = np.arange(ATTN_BLOCK)[:, None]
    ki = np.arange(2 * ATTN_BLOCK)[None, :]
    steps = qi + ATTN_BLOCK - ki
    band = (steps >= 0) & (steps <= w_sub)
    bucket = _t5_bucket(np.clip(steps, 0, w_sub) * dilation)
    key_exists = (np.arange(n_blocks)[:, None, None] > 0) | (ki[None] >= ATTN_BLOCK)
    return bucket, band[None] & key_exists


def _dilated_branch(q, k, v, rel_bias, window, dilation):
    b, h, s, e = q.shape
    seg = s // dilation
    n_blocks = -(-seg // ATTN_BLOCK)
    seg_pad = n_blocks * ATTN_BLOCK

    def to_blocks(t):
        t = t.reshape(b, h, seg, dilation, e).transpose(0, 1, 3, 2, 4)
        t = jnp.pad(t, ((0, 0), (0, 0), (0, 0), (0, seg_pad - seg), (0, 0)))
        return t.reshape(b, h, dilation, n_blocks, ATTN_BLOCK, e)

    def with_prev(t):
        prev = jnp.pad(t[:, :, :, :-1], ((0, 0), (0, 0), (0, 0), (1, 0), (0, 0), (0, 0)))
        return jnp.concatenate([prev, t], axis=-2)

    qb = to_blocks(q)
    kk = with_prev(to_blocks(k))
    vv = with_prev(to_blocks(v)).astype(jnp.float32)
    bucket, mask = _branch_pattern(window, dilation, n_blocks)
    bias = rel_bias[bucket].astype(jnp.float32).transpose(2, 0, 1)
    logits = jnp.einsum('bhrnqe,bhrnke->bhrnqk', qb, kk).astype(jnp.float32)
    logits = logits * (HEAD_DIM ** -0.5) + bias[None, :, None, None]
    logits = jnp.where(mask[None, None, None], logits, -jnp.inf)
    m = logits.max(-1, keepdims=True)
    p = jnp.exp(logits - m)
    den = p.sum(-1)
    o = jnp.einsum('bhrnqk,bhrnke->bhrnqe', p, vv) / den[..., None]
    lse = m[..., 0] + jnp.log(den)
    o = o.reshape(b, h, dilation, seg_pad, e)[:, :, :, :seg].transpose(0, 1, 3, 2, 4).reshape(b, h, s, e)
    lse = lse.reshape(b, h, dilation, seg_pad)[:, :, :, :seg].transpose(0, 1, 3, 2).reshape(b, h, s)
    return o, lse


def _dilated_attention(q, k, v, rel_bias):
    b, h, s, e = q.shape
    outs, lses = [], []
    for window, dilation in DILATED_BRANCHES:
        o, lse = _dilated_branch(q, k, v, rel_bias, window, dilation)
        outs.append(o)
        lses.append(lse)
    wts = jax.nn.softmax(jnp.stack(lses), axis=0)
    o = jnp.einsum('gbhs,gbhse->bhse', wts, jnp.stack(outs))
    return o.transpose(0, 2, 1, 3).reshape(b, s, h * e)


def _short_conv(cx, gate_b, gate_c, conv_w):
    u = gate_c * cx
    y = lax.conv_general_dilated(u, conv_w[:, None, :].astype(u.dtype), window_strides=(1,),
                                 padding=((CONV_K - 1, 0),),
                                 dimension_numbers=('NWC', 'WIO', 'NWC'),
                                 feature_group_count=CONV_WIDTH)
    return gate_b * y


def _swiglu(x, wg, wu, wd):
    return (jax.nn.silu(x @ wg) * (x @ wu)) @ wd


def _route(xf, w_router, router_bias):
    n = xf.shape[0]
    scores = jax.nn.sigmoid((xf @ w_router).astype(jnp.float32))
    biased = scores + router_bias.astype(jnp.float32)
    grouped = biased.reshape(n, N_EXPERT_GROUPS, N_EXPERTS // N_EXPERT_GROUPS)
    group_score = lax.top_k(grouped, 2)[0].sum(-1)
    _, top_groups = lax.top_k(group_score, TOPK_GROUPS)
    group_keep = jax.nn.one_hot(top_groups, N_EXPERT_GROUPS, dtype=jnp.float32).sum(-2) > 0
    expert_keep = jnp.repeat(group_keep, N_EXPERTS // N_EXPERT_GROUPS, axis=-1)
    _, top_idx = lax.top_k(jnp.where(expert_keep, biased, -jnp.inf), TOP_K)
    gate = jnp.take_along_axis(scores, top_idx, axis=-1)
    gate = gate / gate.sum(-1, keepdims=True) * ROUTED_SCALE
    return top_idx, gate


def _routed_experts(xf, top_idx, gate, w_gate, w_up, w_down):
    n_tok, d = xf.shape
    m = n_tok * TOP_K
    flat_e = top_idx.reshape(-1).astype(jnp.int32)
    flat_tok = jnp.arange(m, dtype=jnp.int32) // TOP_K
    flat_w = gate.reshape(-1).astype(xf.dtype)
    order = jnp.argsort(flat_e)
    se, stok, sw = flat_e[order], flat_tok[order], flat_w[order]
    counts = jnp.bincount(flat_e, length=N_EXPERTS).astype(jnp.int32)
    starts = jnp.cumsum(counts) - counts
    padded = (counts + MOE_BLOCK - 1) // MOE_BLOCK * MOE_BLOCK
    pends = jnp.cumsum(padded)
    pstarts = pends - padded
    pos = pstarts[se] + jnp.arange(m, dtype=jnp.int32) - starts[se]
    n_blocks = (m + N_EXPERTS * (MOE_BLOCK - 1) + MOE_BLOCK - 1) // MOE_BLOCK
    rows = n_blocks * MOE_BLOCK
    buf_tok = jnp.full((rows,), n_tok, jnp.int32).at[pos].set(stok)
    buf_w = jnp.zeros((rows,), xf.dtype).at[pos].set(sw)
    block_e = jnp.searchsorted(pends, jnp.arange(n_blocks, dtype=jnp.int32) * MOE_BLOCK, side='right')
    block_e = jnp.minimum(block_e, N_EXPERTS - 1)
    x_pad = jnp.concatenate([xf, jnp.zeros((1, d), xf.dtype)], axis=0)

    def step(y, blk):
        tok, wgt, e = blk
        xb = x_pad[tok]
        out = _swiglu(xb, w_gate[e], w_up[e], w_down[e]) * wgt[:, None]
        return y.at[tok].add(out.astype(y.dtype)), None

    y, _ = lax.scan(step, jnp.zeros_like(x_pad),
                    (buf_tok.reshape(n_blocks, MOE_BLOCK), buf_w.reshape(n_blocks, MOE_BLOCK), block_e))
    return y[:n_tok]


def setup_inputs(seed: int = 0) -> dict:
    key = jax.random.key(seed)
    ks = jax.random.split(key, 20)
    nrm = jax.random.normal
    L = DEPTH
    return {
        "x": nrm(ks[0], (BATCH, SEQ, D_MODEL), jnp.float32),
        "w_in": nrm(ks[1], (L, D_MODEL, PROJ_WIDTH), jnp.float32) * D_MODEL ** -0.5,
        "conv_w": nrm(ks[2], (L, CONV_K, CONV_WIDTH), jnp.float32) * CONV_K ** -0.5,
        "w_o": nrm(ks[3], (L, D_MODEL, D_MODEL), jnp.float32) * D_MODEL ** -0.5 * DEEPNORM_BETA,
        "ln1_g": 1.0 + 0.05 * nrm(ks[4], (L, D_MODEL), jnp.float32),
        "ln1_b": 0.02 * nrm(ks[5], (L, D_MODEL), jnp.float32),
        "rel_bias": 0.2 * nrm(ks[6], (N_REL_BUCKETS, N_ATTN_HEADS), jnp.float32),
        "w_router": nrm(ks[7], (L, D_MODEL, N_EXPERTS), jnp.float32) * D_MODEL ** -0.5,
        "router_bias": 0.01 * nrm(ks[8], (L, N_EXPERTS), jnp.float32),
        "exp_w_gate": nrm(ks[9], (L, N_EXPERTS, D_MODEL, EXPERT_DIM), jnp.float32) * D_MODEL ** -0.5,
        "exp_w_up": nrm(ks[10], (L, N_EXPERTS, D_MODEL, EXPERT_DIM), jnp.float32) * D_MODEL ** -0.5,
        "exp_w_down": nrm(ks[11], (L, N_EXPERTS, EXPERT_DIM, D_MODEL), jnp.float32) * EXPERT_DIM ** -0.5 * DEEPNORM_BETA,
        "sh_w_gate": nrm(ks[12], (L, D_MODEL, SHARED_DIM), jnp.float32) * D_MODEL ** -0.5,
        "sh_w_up": nrm(ks[13], (L, D_MODEL, SHARED_DIM), jnp.float32) * D_MODEL ** -0.5,
        "sh_w_down": nrm(ks[14], (L, SHARED_DIM, D_MODEL), jnp.float32) * SHARED_DIM ** -0.5 * DEEPNORM_BETA,
        "ln2_g": 1.0 + 0.05 * nrm(ks[15], (L, D_MODEL), jnp.float32),
        "ln2_b": 0.02 * nrm(ks[16], (L, D_MODEL), jnp.float32),
    }


def reference(x, w_in, conv_w, w_o, ln1_g, ln1_b, rel_bias, w_router, router_bias,
              exp_w_gate, exp_w_up, exp_w_down, sh_w_gate, sh_w_up, sh_w_down, ln2_g, ln2_b):
    b, s, d = x.shape
    for layer in range(DEPTH):
        proj = x @ w_in[layer]
        q, k, v, cx, cb, cc = jnp.split(proj, SPLIT_POINTS, axis=-1)
        heads = lambda t: t.reshape(b, s, N_ATTN_HEADS, HEAD_DIM).transpose(0, 2, 1, 3)
        attn = _dilated_attention(heads(q), heads(k), heads(v), rel_bias)
        conv = _short_conv(cx, cb, cc, conv_w[layer])
        mix = jnp.concatenate([attn.astype(x.dtype), conv], axis=-1) @ w_o[layer]
        x = _layer_norm(DEEPNORM_ALPHA * x + mix, ln1_g[layer], ln1_b[layer])
        xf = x.reshape(b * s, d)
        top_idx, gate = _route(xf, w_router[layer], router_bias[layer])
        routed = _routed_experts(xf, top_idx, gate, exp_w_gate[layer], exp_w_up[layer], exp_w_down[layer])
        shared = _swiglu(xf, sh_w_gate[layer], sh_w_up[layer], sh_w_down[layer])
        ffn = (routed + shared).reshape(b, s, d)
        x = _layer_norm(DEEPNORM_ALPHA * x + ffn, ln2_g[layer], ln2_b[layer])
    return x
```

```cpp
#include <hip/hip_runtime.h>
#include <cstdio>
#include <cstdint>
#include <cmath>

#define GAS __attribute__((address_space(1)))
#define LAS __attribute__((address_space(3)))
typedef unsigned short bf16_t;
typedef short bf16x8 __attribute__((ext_vector_type(8)));
typedef short s16x4 __attribute__((ext_vector_type(4)));
typedef float f32x4 __attribute__((ext_vector_type(4)));
typedef float f32x16 __attribute__((ext_vector_type(16)));
typedef unsigned u32x4 __attribute__((ext_vector_type(4)));
typedef int i32x8 __attribute__((ext_vector_type(8)));
typedef int i32x4 __attribute__((ext_vector_type(4)));
typedef unsigned u32x8 __attribute__((ext_vector_type(8)));
typedef unsigned u32x2 __attribute__((ext_vector_type(2)));
typedef float f32x2_t __attribute__((ext_vector_type(2)));
typedef __bf16 bf16x2_t __attribute__((ext_vector_type(2)));
typedef short v4i16_t __attribute__((ext_vector_type(4)));

__device__ __forceinline__ unsigned cvtpk(float lo, float hi) { f32x2_t v = {lo, hi}; bf16x2_t b = __builtin_convertvector(v, bf16x2_t); return __builtin_bit_cast(unsigned, b); }
__device__ __forceinline__ float bflo(unsigned u) { return __builtin_bit_cast(float, u << 16); }
__device__ __forceinline__ float bfhi(unsigned u) { return __builtin_bit_cast(float, u & 0xffff0000u); }

__device__ __forceinline__ int opaque_tid() { int t = threadIdx.x; asm volatile("" : "+v"(t)); return t; }
namespace pg8 {
constexpr int BM = 256, BK = 64, HALF = 128, HTB = HALF * BK * 2, STAGE_BYTES = 8 * HTB;
__host__ __device__ __forceinline__ int lds_byte(int r, int c) { const int st = (r >> 4) * 2 + (c >> 5), rr = r & 15, cc = c & 31, ob = rr * 64 + cc * 2; return st * 1024 + (ob ^ (((ob >> 9) & 1) << 5)); }
__host__ __device__ __forceinline__ void stage_rc(int b, int& R, int& C) { const int st = b / 1024, sb = b % 1024, swz = sb ^ (((sb >> 9) & 1) << 5); R = (st >> 1) * 16 + swz / 64; C = (st & 1) * 32 + (swz % 64) / 2; }
__host__ __device__ __forceinline__ int perm32(int rho) { const int n = rho >> 4, i = rho & 15; return 8 * (i >> 2) + 4 * n + (i & 3); }

struct Unit { int pm, pn, aux; };

template <class Epi, class Sched, bool ALIGN_EPI, bool F8 = false>
__device__ __forceinline__ void gemm_phase(LAS unsigned char* lds, const char* Abase, const int K, const Sched& S, const Epi& E) {
    const int tid = opaque_tid(), wid = __builtin_amdgcn_readfirstlane(tid >> 6), lane = tid & 63, wr = wid >> 2, wc = wid & 3, fr = lane & 15, fq = lane >> 4;
    const int nt = K / BK;
    int RA[2], CA[2]; unsigned voffB[2];
#pragma unroll
    for (int i = 0; i < 2; ++i) { int R, C; stage_rc(tid * 16 + i * 8192, R, C); const int Rb = Epi::PERM ? ((R & ~31) + perm32(R & 31)) : R; RA[i] = R; CA[i] = C; voffB[i] = (unsigned)(Rb * K + C) * 2u; }
    const size_t kstep = (size_t)(BK * 2);
    const size_t hstepB = (size_t)HALF * K * 2;
    const unsigned ldsw = (unsigned)wid * 1024u;
    const int aoff = lds_byte(wr * 64 + fr, fq * 8), boff = lds_byte(wc * 32 + fr, fq * 8);
#define PG8_SA(b, h) (((b) * 2 + (h)) * HTB)
#define PG8_SB(b, h) ((4 + (b) * 2 + (h)) * HTB)
#define PG8_STAGE_B(bufoff, gbase) do { _Pragma("unroll") for (int _i = 0; _i < 2; ++_i) \
        __builtin_amdgcn_global_load_lds((const unsigned*)((const char*)(gbase) + voffB[_i]), (LAS unsigned*)(lds + (bufoff) + ldsw + _i * 8192), 16, 0, 0); } while (0)
#define PG8_STAGE_A(bufoff, kptr, vo, h) do { _Pragma("unroll") for (int _i = 0; _i < 2; ++_i) \
        __builtin_amdgcn_global_load_lds((const unsigned*)((const char*)(kptr) + (vo)[h][_i]), (LAS unsigned*)(lds + (bufoff) + ldsw + _i * 8192), 16, 0, 0); } while (0)
#define PG8_LDA(dst, b, h) do { _Pragma("unroll") for (int m = 0; m < 4; ++m) { if constexpr (F8) { const u32x4 lo_ = *(const LAS u32x4*)(lds + PG8_SA(b, h) + aoff + m * 2048), hi_ = *(const LAS u32x4*)(lds + PG8_SA(b, h) + aoff + m * 2048 + 1024); \
            dst##8[m] = __builtin_shufflevector(lo_, hi_, 0, 1, 2, 3, 4, 5, 6, 7); } \
        else { _Pragma("unroll") for (int k = 0; k < 2; ++k) dst[m][k] = *(const LAS bf16x8*)(lds + PG8_SA(b, h) + aoff + m * 2048 + k * 1024); } } } while (0)
#define PG8_LDB(dst, b, h) do { _Pragma("unroll") for (int n = 0; n < 2; ++n) { if constexpr (F8) { const u32x4 lo_ = *(const LAS u32x4*)(lds + PG8_SB(b, h) + boff + n * 2048), hi_ = *(const LAS u32x4*)(lds + PG8_SB(b, h) + boff + n * 2048 + 1024); \
            dst##8[n] = __builtin_shufflevector(lo_, hi_, 0, 1, 2, 3, 4, 5, 6, 7); } \
        else { _Pragma("unroll") for (int k = 0; k < 2; ++k) dst[n][k] = *(const LAS bf16x8*)(lds + PG8_SB(b, h) + boff + n * 2048 + k * 1024); } } } while (0)
#define PG8_MMA(ai, bj, At, Bt) do { __builtin_amdgcn_s_setprio(1); _Pragma("unroll") for (int m = 0; m < 4; ++m) _Pragma("unroll") for (int n = 0; n < 2; ++n) { \
        if constexpr (F8) asm volatile("v_mfma_scale_f32_16x16x128_f8f6f4 %0, %1, %2, %0, %3, %3 op_sel_hi:[0,0,0]" : "+v"(acc[ai][bj][m][n]) : "v"(Bt##8[n]), "v"(At##8[m]), "v"(f8one)); \
        else { _Pragma("unroll") for (int k = 0; k < 2; ++k) acc[ai][bj][m][n] = __builtin_amdgcn_mfma_f32_16x16x32_bf16(Bt[n][k], At[m][k], acc[ai][bj][m][n], 0, 0, 0); } } \
        __builtin_amdgcn_s_setprio(0); } while (0)
#define PG8_WAIT_V(n) asm volatile("s_waitcnt vmcnt(" #n ")" ::: "memory")
#define PG8_WAIT_L(n) asm volatile("s_waitcnt lgkmcnt(" #n ")" ::: "memory")
#define PG8_BAR __builtin_amdgcn_s_barrier()
#define PG8_SCHED __builtin_amdgcn_sched_barrier(0)
    Unit cur, nxt; int ui = 0;
    if (!S.next(0, cur)) return;
    f32x4 acc[2][2][4][2];
#pragma unroll
    for (int a = 0; a < 2; ++a)
#pragma unroll
        for (int b = 0; b < 2; ++b)
#pragma unroll
            for (int m = 0; m < 4; ++m)
#pragma unroll
                for (int n = 0; n < 2; ++n) acc[a][b][m][n] = (f32x4){0.f, 0.f, 0.f, 0.f};
    bf16x8 At[4][2], B0[2][2], B1[2][2];
    u32x8 At8[4], B08[2], B18[2];
    int f8one = 0x7F7F7F7F; asm volatile("" : "+v"(f8one));
    unsigned vc[2][2], vn[2][2];
    S.a_off(cur, RA, CA, vc);
    const char* cB = S.b_base(cur);
    PG8_STAGE_B(PG8_SB(0, 0), cB); PG8_STAGE_B(PG8_SB(0, 1), cB + hstepB); PG8_STAGE_A(PG8_SA(0, 0), Abase, vc, 0); PG8_STAGE_A(PG8_SA(0, 1), Abase, vc, 1);
    if (wr == 1) PG8_BAR;
    PG8_WAIT_V(2); PG8_BAR;
    PG8_STAGE_B(PG8_SB(1, 0), cB + kstep); PG8_STAGE_A(PG8_SA(1, 0), Abase + kstep, vc, 0); PG8_STAGE_B(PG8_SB(1, 1), cB + hstepB + kstep);
    PG8_WAIT_V(6); PG8_BAR;
    for (;;) {
        const bool has_next = S.next(ui + 1, nxt);
        const char* nB = cB;
        if (has_next) { S.a_off(nxt, RA, CA, vn); nB = S.b_base(nxt); }
        else {
#pragma unroll
            for (int h = 0; h < 2; ++h)
#pragma unroll
                for (int i = 0; i < 2; ++i) vn[h][i] = vc[h][i];
        }
#pragma unroll 1
        for (int t = 0; t < nt; t += 2) {
            const bool last = (t == nt - 2);
            const char* ka1 = Abase + (size_t)(t + 1) * kstep;
            const char* ka2 = last ? Abase : Abase + (size_t)(t + 2) * kstep;
            const char* ka3 = ka2 + kstep;
            const char* b2 = last ? nB : cB + (size_t)(t + 2) * kstep;
            const char* b3 = b2 + kstep;
            unsigned v2[2][2];
#pragma unroll
            for (int h = 0; h < 2; ++h)
#pragma unroll
                for (int i = 0; i < 2; ++i) v2[h][i] = last ? vn[h][i] : vc[h][i];
            PG8_LDB(B0, 0, 0); PG8_LDB(B1, 0, 1); PG8_SCHED; PG8_LDA(At, 0, 0); PG8_STAGE_A(PG8_SA(1, 1), ka1, vc, 1);
            PG8_WAIT_V(8); PG8_WAIT_L(0); PG8_BAR; PG8_MMA(0, 0, At, B0); PG8_MMA(0, 1, At, B1); PG8_BAR; PG8_SCHED;
            PG8_LDA(At, 0, 1); PG8_STAGE_B(PG8_SB(0, 0), b2); PG8_STAGE_B(PG8_SB(0, 1), b2 + hstepB); PG8_STAGE_A(PG8_SA(0, 0), ka2, v2, 0);
            PG8_WAIT_V(8); PG8_WAIT_L(0); PG8_BAR; PG8_MMA(1, 0, At, B0); PG8_MMA(1, 1, At, B1); PG8_BAR; PG8_SCHED;
            PG8_LDB(B0, 1, 0); PG8_LDB(B1, 1, 1); PG8_SCHED; PG8_LDA(At, 1, 0); PG8_STAGE_A(PG8_SA(0, 1), ka2, v2, 1);
            PG8_WAIT_V(8); PG8_WAIT_L(0); PG8_BAR; PG8_MMA(0, 0, At, B0); PG8_MMA(0, 1, At, B1); PG8_BAR; PG8_SCHED;
            PG8_LDA(At, 1, 1); PG8_STAGE_B(PG8_SB(1, 0), b3); PG8_STAGE_B(PG8_SB(1, 1), b3 + hstepB); PG8_STAGE_A(PG8_SA(1, 0), ka3, v2, 0);
            PG8_WAIT_V(8); PG8_WAIT_L(0); PG8_BAR; PG8_MMA(1, 0, At, B0); PG8_MMA(1, 1, At, B1); PG8_BAR; PG8_SCHED;
        }
        if constexpr (F8) asm volatile("s_nop 15\n\ts_nop 15" ::: "memory");
        if constexpr (ALIGN_EPI) { if (wr == 0) PG8_BAR; }
        E(acc, cur, wr, wc, fr, fq);
        if (!has_next) break;
#pragma unroll
        for (int a = 0; a < 2; ++a)
#pragma unroll
            for (int b = 0; b < 2; ++b)
#pragma unroll
                for (int m = 0; m < 4; ++m)
#pragma unroll
                    for (int n = 0; n < 2; ++n) acc[a][b][m][n] = (f32x4){0.f, 0.f, 0.f, 0.f};
        cur = nxt; cB = nB; ++ui;
#pragma unroll
        for (int h = 0; h < 2; ++h)
#pragma unroll
            for (int i = 0; i < 2; ++i) vc[h][i] = vn[h][i];
        if constexpr (ALIGN_EPI) { if (wr == 1) PG8_BAR; }
    }
    PG8_WAIT_V(0);
    if constexpr (!ALIGN_EPI) { if (wr == 0) PG8_BAR; }
    PG8_BAR;
#undef PG8_SA
#undef PG8_SB
#undef PG8_STAGE_A
#undef PG8_STAGE_B
#undef PG8_LDA
#undef PG8_LDB
#undef PG8_MMA
#undef PG8_WAIT_V
#undef PG8_WAIT_L
#undef PG8_BAR
#undef PG8_SCHED
}
}

constexpr int DM = 1024, SEQ = 2048, NTOK = 65536, PROJW = 3072, NH = 12, NEXP = 256, EDIM = 256;
constexpr int HALF_TOK = NTOK / 2;
constexpr float SLOT_SCALE = 16.f, SLOT_INV = 1.f / 16.f;
constexpr float X_SCALE = 4.f, W13_SCALE = 16.f;
constexpr float ALPHA = 1.189207115002721f, LN_EPS = 1e-5f, LOG2E = 1.4426950408889634f;
constexpr int NWAVES = 8;

constexpr size_t MiB = (size_t)1 << 20;
constexpr size_t WS_CTL = 0, CTL_ZERO_BYTES = 1 * MiB;
constexpr size_t WS_BIAS = 1 * MiB;
constexpr size_t WS_WIN = 2 * MiB;
constexpr size_t WS_WO = 8 * MiB;
constexpr size_t WS_WR = 10 * MiB;
constexpr size_t WS_W13 = 12 * MiB;
constexpr size_t WS_WD = 269 * MiB;
constexpr size_t WS_XB = 398 * MiB;
constexpr size_t WS_PROJ = 526 * MiB;
constexpr size_t WS_CONVIN = WS_PROJ + 288 * MiB;
constexpr size_t WS_LSE = 910 * MiB;
constexpr size_t WS_LOGIT = 526 * MiB;
constexpr size_t WS_TOPE = 590 * MiB;
constexpr size_t WS_TOPW = 592 * MiB;
constexpr size_t WS_ROWSRC = 594 * MiB;
constexpr size_t WS_ROWW = 597 * MiB;
constexpr size_t WS_H = 600 * MiB;
constexpr size_t WS_ROWPTR = 952 * MiB;
constexpr size_t WS_PANEL = 958 * MiB;
constexpr size_t WS_X8 = 768 * MiB;
constexpr size_t WS_DUMP = 976 * MiB;
constexpr size_t WS_NEED = 1024 * MiB;
constexpr int MAXROWS = NTOK * 8 + 256 * 255 + NTOK;
constexpr int MAXPANELS = MAXROWS / 256;
static_assert((size_t)MAXROWS * 512 <= 320 * MiB && (size_t)MAXROWS * 8 <= 6 * MiB && (size_t)MAXROWS * 4 <= 3 * MiB, "ws map");
constexpr int NSEG = 257;
constexpr int CW_BAR = 4096, CW_CNT = 16384, CW_CUR = 17408, CW_PT = 18433, CW_TEAM = 20480;

constexpr int RING_BYTES = 143360;
constexpr int ATT_HALF = 71680, ATT_K = 0, ATT_V = 36864, ATT_TBL = 69632, ATT_SC = 70400;
constexpr int MISC_OFF = RING_BYTES;
constexpr int LDS_BYTES = 147456;

#define ST_WT(p, v) __hip_atomic_store((p), (v), __ATOMIC_RELAXED, __HIP_MEMORY_SCOPE_AGENT)
#define LDS_WAIT() asm volatile("s_waitcnt lgkmcnt(0)" ::: "memory")
#define VM_WAIT() asm volatile("s_waitcnt vmcnt(0)" ::: "memory")

#define XB_TMO      128
#define XB_XCNT(j)  (256  + 64 * (j))
#define XB_XSUB(j)  (1280 + 64 * (j))
#define XB_XGEN(j)  (2304 + 64 * (j))
#define XB_TOP      3328
#define XB_TOPGEN   3392
#define XCD_BAR_WORDS 3456
#define XB_SPIN_CAP (1u << 18)
__device__ __forceinline__ unsigned xb_ld(unsigned* p)              { return __hip_atomic_load(p, __ATOMIC_RELAXED, __HIP_MEMORY_SCOPE_AGENT); }
__device__ __forceinline__ unsigned xb_add(unsigned* p, unsigned v) { return __hip_atomic_fetch_add(p, v, __ATOMIC_RELAXED, __HIP_MEMORY_SCOPE_AGENT); }
__device__ __forceinline__ unsigned xb_xcc_id() { return (unsigned)__builtin_amdgcn_s_getreg((3 << 11) | 20) & 0xFu; }
#define XB_SPIN(cond, bar) do { unsigned _sp = 0; while (cond) { __builtin_amdgcn_s_sleep(1); \
    if ((++_sp & 255u) == 0u) { if (xb_ld(&(bar)[XB_TMO])) break; if (_sp > XB_SPIN_CAP) { atomicAdd(&(bar)[XB_TMO], 1u); break; } } } } while (0)
struct XcdBarrier { unsigned* bar; unsigned x; volatile LAS unsigned* st; };
__device__ __forceinline__ XcdBarrier xcd_barrier_post(unsigned* bar, volatile LAS unsigned* st) {
    XcdBarrier b; b.bar = bar; b.x = xb_xcc_id(); b.st = st;
    if (threadIdx.x == 0) (void)xb_add(&bar[XB_XCNT(b.x)], 1u);
    return b;
}
__device__ __forceinline__ void xcd_barrier_complete(unsigned* bar, unsigned x, unsigned& nloc, unsigned& nx) {
    const unsigned G = gridDim.x * gridDim.y * gridDim.z;
    unsigned sum, cnt, mine, sp = 0u;
    for (;;) {
        sum = 0u; cnt = 0u; mine = 0u;
#pragma unroll
        for (unsigned j = 0; j < 16; ++j) { const unsigned c = xb_ld(&bar[XB_XCNT(j)]); sum += c; cnt += (c > 0u) ? 1u : 0u; mine = (j == x) ? c : mine; }
        if (sum == G) break;
        __builtin_amdgcn_s_sleep(1);
        if ((++sp & 255u) == 0u) { if (xb_ld(&bar[XB_TMO])) break; if (sp > XB_SPIN_CAP) { atomicAdd(&bar[XB_TMO], 1u); break; } }
    }
    nloc = mine > 0u ? mine : 1u; nx = cnt > 0u ? cnt : 1u;
}
__device__ __forceinline__ void xcd_barrier(const XcdBarrier& b) {
    asm volatile("s_waitcnt vmcnt(0)" ::: "memory");
    __syncthreads();
    if (threadIdx.x == 0) {
        unsigned* bar = b.bar;
        __builtin_amdgcn_s_waitcnt(0);
        unsigned nloc = b.st[0], nx = b.st[1];
        if (nloc == 0u) { xcd_barrier_complete(bar, b.x, nloc, nx); b.st[0] = nloc; b.st[1] = nx; }
        const unsigned old = xb_add(&bar[XB_XSUB(b.x)], 1u);
        const unsigned gen = old / nloc;
        if (old + 1u == (gen + 1u) * nloc) {
            __builtin_amdgcn_fence(__ATOMIC_RELEASE, "agent");
            asm volatile("s_waitcnt vmcnt(0)" ::: "memory");
            const unsigned og = xb_add(&bar[XB_TOP], 1u);
            const unsigned tg = og / nx;
            if (og + 1u == (tg + 1u) * nx) xb_add(&bar[XB_TOPGEN], 1u);
            else XB_SPIN(xb_ld(&bar[XB_TOPGEN]) == tg, bar);
            __builtin_amdgcn_fence(__ATOMIC_ACQUIRE, "agent");
            xb_add(&bar[XB_XGEN(b.x)], 1u);
            asm volatile("s_waitcnt vmcnt(0)" ::: "memory");
        } else {
            XB_SPIN(xb_ld(&bar[XB_XGEN(b.x)]) == gen, bar);
            __builtin_amdgcn_fence(__ATOMIC_ACQUIRE, "agent");
            asm volatile("s_waitcnt vmcnt(0)" ::: "memory");
        }
    }
    __syncthreads();
}

__device__ __forceinline__ void team_barrier(unsigned* ctr, unsigned target) {
    asm volatile("s_waitcnt vmcnt(0)" ::: "memory");
    __syncthreads();
    if (threadIdx.x == 0) {
        __builtin_amdgcn_fence(__ATOMIC_RELEASE, "agent");
        asm volatile("s_waitcnt vmcnt(0)" ::: "memory");
        (void)xb_add(ctr, 1u);
        for (unsigned sp = 0; xb_ld(ctr) < target && sp < (1u << 24); ++sp) __builtin_amdgcn_s_sleep(1);
        __builtin_amdgcn_fence(__ATOMIC_ACQUIRE, "agent");
        asm volatile("s_waitcnt vmcnt(0)" ::: "memory");
    }
    __syncthreads();
}

struct Frame {
    LAS unsigned char* lds;
    unsigned* ctl;
    int vcu, G;
    unsigned char* ws; float* out;
    const float *x, *w_in, *conv_w, *w_o, *ln1_g, *ln1_b, *rel_bias, *w_router, *router_bias, *eg, *eu, *ed, *sg, *su, *sd, *ln2_g, *ln2_b;
};
__device__ __forceinline__ float wave_sum(float v) {
#pragma unroll
    for (int o = 1; o < 64; o <<= 1) v += __shfl_xor(v, o);
    return v;
}

struct DenseOrder {
    int nM, nN, nwg, G, c, K; const char* Bt;
    __device__ __forceinline__ void init(int M, int N, int K_, int G_, int c_, const void* Bt_) { nM = M / 256; nN = N / 256; nwg = nM * nN; G = G_; c = c_; K = K_; Bt = (const char*)Bt_; }
    __device__ __forceinline__ bool next(int i, pg8::Unit& u) const {
        const long L = (long)i * G + c; if (L >= nwg) return false;
        int wgid = (int)L; { const int q = nwg / 8, r = nwg % 8, xcd = wgid % 8, off = wgid / 8; wgid = (xcd < r ? xcd * (q + 1) : r * (q + 1) + (xcd - r) * q) + off; }
        const int nig = 8 * nN, gid = wgid / nig, fm = gid * 8, gsz = (nM - fm) < 8 ? (nM - fm) : 8;
        u.pm = fm + ((wgid % nig) % gsz); u.pn = (wgid % nig) / gsz; u.aux = 0; return true;
    }
    __device__ __forceinline__ void a_off(const pg8::Unit& u, const int (&R)[2], const int (&C)[2], unsigned (&vo)[2][2]) const {
#pragma unroll
        for (int h = 0; h < 2; ++h)
#pragma unroll
            for (int i = 0; i < 2; ++i) vo[h][i] = (unsigned)((u.pm * 256 + 128 * h + R[i]) * K + C[i]) * 2u;
    }
    __device__ __forceinline__ const char* b_base(const pg8::Unit& u) const { return Bt + (size_t)u.pn * 256 * K * 2; }
};
struct MoeOrder {
    int nunits, G, c, shift, p0, K; const int* panel_e; const int* row_src; const char* W; size_t wbytes;
    __device__ __forceinline__ bool next(int i, pg8::Unit& u) const {
        const long L = (long)i * G + c; if (L >= nunits) return false;
        u.pm = p0 + (int)(L >> shift); u.pn = (int)(L & ((1 << shift) - 1)); u.aux = __builtin_amdgcn_readfirstlane(panel_e[u.pm]); return true;
    }
    __device__ __forceinline__ void a_off(const pg8::Unit& u, const int (&R)[2], const int (&C)[2], unsigned (&vo)[2][2]) const {
#pragma unroll
        for (int h = 0; h < 2; ++h)
#pragma unroll
            for (int i = 0; i < 2; ++i) {
                const int row = u.pm * 256 + 128 * h + R[i];
                vo[h][i] = row_src ? ((unsigned)row_src[row] * (unsigned)(K * 2) + (unsigned)C[i] * 2u) : ((unsigned)(row * K + C[i]) * 2u);
            }
    }
    __device__ __forceinline__ const char* b_base(const pg8::Unit& u) const { return W + (size_t)u.aux * wbytes + (size_t)u.pn * 256 * K * 2; }
};

struct EpiProj {
    static constexpr bool PERM = true;
    bf16_t* QKV; bf16_t* CV;
    __device__ __forceinline__ void operator()(const f32x4 (&acc)[2][2][4][2], const pg8::Unit& u, int wr, int wc, int fr, int fq) const {
        const int row0 = u.pm * 256 + wr * 64 + fr;
#pragma unroll
        for (int bj = 0; bj < 2; ++bj) { const int col = u.pn * 256 + bj * 128 + wc * 32 + 8 * fq;
            bf16_t* base; size_t rstride;
            if (col < 2304) { const int which = col / 768, hc = col % 768, h = hc >> 6, d = hc & 63; base = QKV + ((size_t)which * 32 * NH + h) * (SEQ * 64) + d; rstride = 0; }
            else { base = CV + (col - 2304); rstride = 1; }
#pragma unroll
            for (int ai = 0; ai < 2; ++ai)
#pragma unroll
                for (int m = 0; m < 4; ++m) { const int row = row0 + ai * 128 + m * 16; const int b = row >> 11, t = row & (SEQ - 1);
                    bf16_t* p = rstride ? base + (size_t)row * 768 : base + (size_t)b * NH * (SEQ * 64) + (size_t)t * 64;
                    const f32x4 v0 = acc[ai][bj][m][0], v1 = acc[ai][bj][m][1];
                    constexpr float r = 1.f / (X_SCALE * W13_SCALE);
                    u32x4 w; w.x = cvtpk(v0[0] * r, v0[1] * r); w.y = cvtpk(v0[2] * r, v0[3] * r); w.z = cvtpk(v1[0] * r, v1[1] * r); w.w = cvtpk(v1[2] * r, v1[3] * r);
                    *(u32x4*)p = w; }
        }
    }
};
struct EpiF32 {
    static constexpr bool PERM = false;
    float* C; int ldc;
    __device__ __forceinline__ void operator()(const f32x4 (&acc)[2][2][4][2], const pg8::Unit& u, int wr, int wc, int fr, int fq) const {
        const int row0 = u.pm * 256 + wr * 64 + fr, col0 = u.pn * 256 + wc * 32 + 4 * fq;
#pragma unroll
        for (int ai = 0; ai < 2; ++ai)
#pragma unroll
            for (int m = 0; m < 4; ++m) { float* rowp = C + (size_t)(row0 + ai * 128 + m * 16) * ldc + col0;
#pragma unroll
                for (int bj = 0; bj < 2; ++bj)
#pragma unroll
                    for (int n = 0; n < 2; ++n) *(f32x4*)(rowp + bj * 128 + n * 16) = acc[ai][bj][m][n]; }
    }
};
struct EpiWo {
    static constexpr bool PERM = true;
    bf16_t* Z; const float* X;
    __device__ __forceinline__ void operator()(const f32x4 (&acc)[2][2][4][2], const pg8::Unit& u, int wr, int wc, int fr, int fq) const {
        const int row0 = u.pm * 256 + wr * 64 + fr, col0 = u.pn * 256 + wc * 32 + 8 * fq;
#pragma unroll
        for (int ai = 0; ai < 2; ++ai)
#pragma unroll
            for (int m = 0; m < 4; ++m) { const size_t ro = (size_t)(row0 + ai * 128 + m * 16) * DM + col0;
#pragma unroll
                for (int bj = 0; bj < 2; ++bj) { const f32x4 x0 = *(const f32x4*)(X + ro + bj * 128), x1 = *(const f32x4*)(X + ro + bj * 128 + 4);
                    const f32x4 v0 = x0 * ALPHA + acc[ai][bj][m][0], v1 = x1 * ALPHA + acc[ai][bj][m][1];
                    u32x4 w; w.x = cvtpk(v0[0], v0[1]); w.y = cvtpk(v0[2], v0[3]); w.z = cvtpk(v1[0], v1[1]); w.w = cvtpk(v1[2], v1[3]);
                    *(u32x4*)(Z + ro + bj * 128) = w; } }
    }
};
__device__ __forceinline__ float silu_mul(float g, float u) { const float e = __builtin_amdgcn_exp2f(-g * LOG2E); return g * __builtin_amdgcn_rcpf(1.f + e) * u; }
constexpr float H_SCALE = 8.f, WD_SCALE = 8.f;
__device__ __forceinline__ float h8(float g, float u) { constexpr float r = 1.f / (X_SCALE * W13_SCALE); return __builtin_amdgcn_fmed3f(silu_mul(g * r, u * r) * H_SCALE, -448.f, 448.f); }
struct EpiGU {
    static constexpr bool PERM = true;
    unsigned char* H;
    __device__ __forceinline__ void operator()(const f32x4 (&acc)[2][2][4][2], const pg8::Unit& u, int wr, int wc, int fr, int fq) const {
        const int row0 = u.pm * 256 + wr * 64 + fr, col0 = u.pn * 128 + wc * 32 + 8 * fq;
#pragma unroll
        for (int ai = 0; ai < 2; ++ai)
#pragma unroll
            for (int m = 0; m < 4; ++m) { unsigned char* rowp = H + (size_t)(row0 + ai * 128 + m * 16) * EDIM + col0;
                const f32x4 g0 = acc[ai][0][m][0], g1 = acc[ai][0][m][1], u0 = acc[ai][1][m][0], u1 = acc[ai][1][m][1];
                int w0 = 0, w1 = 0;
                w0 = __builtin_amdgcn_cvt_pk_fp8_f32(h8(g0[0], u0[0]), h8(g0[1], u0[1]), w0, false); w0 = __builtin_amdgcn_cvt_pk_fp8_f32(h8(g0[2], u0[2]), h8(g0[3], u0[3]), w0, true);
                w1 = __builtin_amdgcn_cvt_pk_fp8_f32(h8(g1[0], u1[0]), h8(g1[1], u1[1]), w1, false); w1 = __builtin_amdgcn_cvt_pk_fp8_f32(h8(g1[2], u1[2]), h8(g1[3], u1[3]), w1, true);
                u32x2 w; w.x = (unsigned)w0; w.y = (unsigned)w1;
                *(u32x2*)rowp = w; }
    }
};
__device__ __forceinline__ int t5_bucket(int dist) {
    if (dist < 16) return dist;
    int b = 16;
    b += dist >= 22; b += dist >= 30; b += dist >= 40; b += dist >= 54; b += dist >= 73; b += dist >= 99; b += dist >= 134; b += dist >= 182;
    b += dist >= 246; b += dist >= 332; b += dist >= 450; b += dist >= 609; b += dist >= 825; b += dist >= 1117; b += dist >= 1513;
    return b;
}
__device__ __forceinline__ void transpose_item(const float* W, int N, int k0, int n0, bf16_t* WT, int ldk, int out_row0, LAS float* scr, int lane) {
#pragma unroll 8
    for (int i = 0; i < 32; ++i) { const int kk = 2 * i + (lane >> 5); scr[kk * 33 + (lane & 31)] = W[(size_t)(k0 + kk) * N + n0 + (lane & 31)]; }
    LDS_WAIT(); asm volatile("" ::: "memory");
    const int c = lane & 7;
#pragma unroll
    for (int j = 0; j < 4; ++j) { const int n = (lane >> 3) + 8 * j; const LAS float* s = scr + (8 * c) * 33 + n;
        u32x4 o; o.x = cvtpk(s[0 * 33], s[1 * 33]); o.y = cvtpk(s[2 * 33], s[3 * 33]); o.z = cvtpk(s[4 * 33], s[5 * 33]); o.w = cvtpk(s[6 * 33], s[7 * 33]);
        *(u32x4*)(WT + (size_t)(out_row0 + n) * ldk + k0 + 8 * c) = o; }
    LDS_WAIT(); asm volatile("" ::: "memory");
}
__device__ __forceinline__ void transpose_item8(const float* W, int N, int k0, int n0, unsigned char* WT, int ldk, int out_row0, float sc, LAS float* scr, int lane) {
#pragma unroll 8
    for (int i = 0; i < 32; ++i) { const int kk = 2 * i + (lane >> 5); scr[kk * 33 + (lane & 31)] = W[(size_t)(k0 + kk) * N + n0 + (lane & 31)]; }
    LDS_WAIT(); asm volatile("" ::: "memory");
    const int c = lane & 3;
#pragma unroll
    for (int j = 0; j < 2; ++j) { const int n = (lane >> 2) + 16 * j; const LAS float* s = scr + (16 * c) * 33 + n;
        int w0 = 0, w1 = 0, w2 = 0, w3 = 0;
        w0 = __builtin_amdgcn_cvt_pk_fp8_f32(s[0 * 33] * sc, s[1 * 33] * sc, w0, false); w0 = __builtin_amdgcn_cvt_pk_fp8_f32(s[2 * 33] * sc, s[3 * 33] * sc, w0, true);
        w1 = __builtin_amdgcn_cvt_pk_fp8_f32(s[4 * 33] * sc, s[5 * 33] * sc, w1, false); w1 = __builtin_amdgcn_cvt_pk_fp8_f32(s[6 * 33] * sc, s[7 * 33] * sc, w1, true);
        w2 = __builtin_amdgcn_cvt_pk_fp8_f32(s[8 * 33] * sc, s[9 * 33] * sc, w2, false); w2 = __builtin_amdgcn_cvt_pk_fp8_f32(s[10 * 33] * sc, s[11 * 33] * sc, w2, true);
        w3 = __builtin_amdgcn_cvt_pk_fp8_f32(s[12 * 33] * sc, s[13 * 33] * sc, w3, false); w3 = __builtin_amdgcn_cvt_pk_fp8_f32(s[14 * 33] * sc, s[15 * 33] * sc, w3, true);
        u32x4 o; o.x = (unsigned)w0; o.y = (unsigned)w1; o.z = (unsigned)w2; o.w = (unsigned)w3;
        *(u32x4*)(WT + (size_t)(out_row0 + n) * ldk + k0 + 16 * c) = o; }
    LDS_WAIT(); asm volatile("" ::: "memory");
}
__device__ __forceinline__ void p0_prologue(Frame& F) {
    const int tid_ = opaque_tid(), lane_ = tid_ & 63, wave_ = __builtin_amdgcn_readfirstlane(tid_ >> 6);
    LAS float* scr = (LAS float*)(F.lds + wave_ * 8448);
    const int gw = F.vcu * NWAVES + wave_, NGW = F.G * NWAVES, lane = lane_;
    bf16_t* win_t = (bf16_t*)(F.ws + WS_WIN); bf16_t* wo_t = (bf16_t*)(F.ws + WS_WO); bf16_t* wr_t = (bf16_t*)(F.ws + WS_WR);
    unsigned char* w13 = F.ws + WS_W13  ; unsigned char* wd = F.ws + WS_WD;
    constexpr int I_IN = 16 * 96, I_O = 16 * 32, I_R = 16 * 8, I_SMALL = I_IN + I_O + I_R;
    for (int it = gw; it < I_SMALL; it += NGW) {
        int r = it;
        if (r < I_IN) { const int kb = r / 96, nb = r % 96; transpose_item8(F.w_in, PROJW, 64 * kb, 32 * nb, (unsigned char*)win_t, DM, 32 * nb, W13_SCALE, scr, lane); continue; } r -= I_IN;
        if (r < I_O) { const int kb = r / 32, nb = r % 32; transpose_item(F.w_o, DM, 64 * kb, 32 * nb, wo_t, DM, 32 * nb, scr, lane); continue; } r -= I_O;
        { const int kb = r / 8, nb = r % 8; transpose_item(F.w_router, NEXP, 64 * kb, 32 * nb, wr_t, DM, 32 * nb, scr, lane); }
    }
    { float* bt = (float*)(F.ws + WS_BIAS);
      for (int i = F.vcu * 512 + tid_; i < 3 * NH * 192; i += F.G * 512) { const int g = i / (NH * 192), r = i % (NH * 192), h = r / 192, e = r % 192, st = e - 32;
        float v = -INFINITY; if (st >= 0 && st <= 128) v = F.rel_bias[t5_bucket(st << (2 * g)) * NH + h] * LOG2E; bt[i] = v; } }
    { const f32x4* xs = (const f32x4*)F.x; u32x4* xd = (u32x4*)(F.ws + WS_XB); const size_t n16 = (size_t)NTOK * DM / 16, stride = (size_t)F.G * 512;
        for (size_t i = (size_t)F.vcu * 512 + tid_; i < n16; i += stride) { u32x4 o; int wv[4];
#pragma unroll
            for (int j = 0; j < 4; ++j) { const f32x4 a = xs[4 * i + j]; int wj = 0;
                wj = __builtin_amdgcn_cvt_pk_fp8_f32(__builtin_amdgcn_fmed3f(a[0] * X_SCALE, -448.f, 448.f), __builtin_amdgcn_fmed3f(a[1] * X_SCALE, -448.f, 448.f), wj, false);
                wj = __builtin_amdgcn_cvt_pk_fp8_f32(__builtin_amdgcn_fmed3f(a[2] * X_SCALE, -448.f, 448.f), __builtin_amdgcn_fmed3f(a[3] * X_SCALE, -448.f, 448.f), wj, true); wv[j] = wj; }
            o.x = (unsigned)wv[0]; o.y = (unsigned)wv[1]; o.z = (unsigned)wv[2]; o.w = (unsigned)wv[3]; xd[i] = o; } }
}

__device__ __forceinline__ float lane_swap_max(float m) { asm volatile("s_nop 7" : "+v"(m)); auto rr = __builtin_amdgcn_permlane32_swap(__float_as_uint(m), __float_as_uint(m), false, false); unsigned r0 = rr[0], r1 = rr[1]; asm volatile("s_nop 7" : "+v"(r0), "+v"(r1)); return fmaxf(__uint_as_float(r0), __uint_as_float(r1)); }
__device__ __forceinline__ float lane_swap_sum(float m) { asm volatile("s_nop 7" : "+v"(m)); auto rr = __builtin_amdgcn_permlane32_swap(__float_as_uint(m), __float_as_uint(m), false, false); unsigned r0 = rr[0], r1 = rr[1]; asm volatile("s_nop 7" : "+v"(r0), "+v"(r1)); return __uint_as_float(r0) + __uint_as_float(r1); }
__device__ __forceinline__ int crow(int r, int hi) { return (r & 3) + 8 * (r >> 2) + 4 * hi; }

template <int GB>
__device__ __forceinline__ void attn_pair(Frame& F, int pair) {
    const int tid_ = opaque_tid(), lane_ = tid_ & 63, wave_ = __builtin_amdgcn_readfirstlane(tid_ >> 6);
    constexpr int DIL = 1 << (2 * GB), NB = 16 / DIL;
    const int tid = tid_, hw = wave_ >> 2, w = wave_ & 3, ht = tid & 255, lane = lane_, r32 = lane & 31, hi = lane >> 5;
    const int u = pair * 2 + hw;
    const int b = u / 192, rem = u % 192, hh = rem >> 4, blk = rem & 15;
    const int r = blk / NB, n = blk % NB;
    LAS unsigned char* base = F.lds + hw * ATT_HALF;
    LAS unsigned char* Kl = base + ATT_K; LAS unsigned char* Vl = base + ATT_V; LAS float* tbl = (LAS float*)(base + ATT_TBL); LAS float* sc = (LAS float*)(base + ATT_SC + w * 256);
    const bf16_t* proj = (const bf16_t*)(F.ws + WS_PROJ);
    bf16_t* A2 = (bf16_t*)(F.ws + WS_XB); float* lse_buf = (float*)(F.ws + WS_LSE);
    const size_t tok0 = (size_t)b * SEQ + r;
    const bf16_t* qh = proj + ((size_t)(0 * 32 + b) * NH + hh) * (SEQ * 64); const bf16_t* kh = proj + ((size_t)(1 * 32 + b) * NH + hh) * (SEQ * 64); const bf16_t* vh = proj + ((size_t)(2 * 32 + b) * NH + hh) * (SEQ * 64);
    if (ht < 192) tbl[ht] = ((const float*)(F.ws + WS_BIAS))[(GB * NH + hh) * 192 + ht];
    {
        const int c = ht & 7, rb = ht >> 3;
        u32x4 kv[8], vv[8];
#pragma unroll
        for (int it = 0; it < 8; ++it) { const int ki = it * 32 + rb, l = 128 * (n - 1) + ki;
            if (l >= 0) { const size_t ro = (size_t)(l * DIL + r) * 64 + c * 8; kv[it] = *(const u32x4*)(kh + ro); vv[it] = *(const u32x4*)(vh + ro); }
            else { kv[it] = (u32x4){0u, 0u, 0u, 0u}; vv[it] = (u32x4){0u, 0u, 0u, 0u}; } }
#pragma unroll
        for (int it = 0; it < 8; ++it) { const int ki = it * 32 + rb;
            *(LAS u32x4*)(Kl + ki * 144 + c * 16) = kv[it];
            const u32x4 v = vv[it]; const int sw = ((ki >> 1) & 1) * 64;
            u32x2 ev, od; ev.x = (v.x & 0xffffu) | (v.y << 16); ev.y = (v.z & 0xffffu) | (v.w << 16); od.x = (v.x >> 16) | (v.y & 0xffff0000u); od.y = (v.z >> 16) | (v.w & 0xffff0000u);
            *(LAS u32x2*)(Vl + ki * 128 + (0 ^ sw) + c * 8) = ev; *(LAS u32x2*)(Vl + ki * 128 + (64 ^ sw) + c * 8) = od; }
    }
    bf16x8 qf[4];
    const int lq = 128 * n + 32 * w + r32;
    { const bf16_t* qs = qh + (size_t)(lq * DIL + r) * 64 + hi * 8;
#pragma unroll
        for (int ds = 0; ds < 4; ++ds) qf[ds] = *(const bf16x8*)(qs + ds * 16); }
    __syncthreads();
    f32x16 S[5];
    constexpr float SC = 0.125f * LOG2E;
#pragma unroll
    for (int jj = 0; jj < 5; ++jj) {
        const int j = w + jj; const bool act = (n > 0) || (j >= 4);
        if (act) {
            f32x16 a;
#pragma unroll
            for (int i = 0; i < 16; ++i) a[i] = 0.f;
            asm volatile("" : "+v"(a));
            const LAS unsigned char* kp = Kl + (32 * j + r32) * 144 + hi * 16;
#pragma unroll
            for (int ds = 0; ds < 4; ++ds) { const bf16x8 kf = *(const LAS bf16x8*)(kp + ds * 32); a = __builtin_amdgcn_mfma_f32_32x32x16_bf16(kf, qf[ds], a, 0, 0, 0); }
            const int ib = 160 - 32 * jj + r32 - 4 * hi;
#pragma unroll
            for (int i = 0; i < 16; ++i) a[i] = a[i] * SC + *(volatile LAS float*)(tbl + (ib - (i & 3) - 8 * (i >> 2)));
            S[jj] = a;
        } else {
#pragma unroll
            for (int i = 0; i < 16; ++i) S[jj][i] = -INFINITY;
        }
    }
    float m = -INFINITY;
#pragma unroll
    for (int jj = 0; jj < 5; ++jj)
#pragma unroll
        for (int i = 0; i < 16; ++i) m = fmaxf(m, S[jj][i]);
    m = lane_swap_max(m);
    float lsum = 0.f;
#pragma unroll
    for (int jj = 0; jj < 5; ++jj)
#pragma unroll
        for (int i = 0; i < 16; ++i) { const float p = __builtin_amdgcn_exp2f(S[jj][i] - m); S[jj][i] = p; lsum += p; }
    lsum = lane_swap_sum(lsum);
    f32x16 o[2];
#pragma unroll
    for (int i = 0; i < 16; ++i) { o[0][i] = 0.f; o[1][i] = 0.f; }
    asm volatile("" : "+v"(o[0]), "+v"(o[1]));
    { const int q4 = (lane & 15) >> 2, p4 = lane & 3, cb = (lane >> 4) & 1, swz = ((q4 >> 1) & 1) * 64;
        const LAS unsigned char* vb = Vl + (4 * hi + q4) * 128 + cb * 32 + p4 * 8;
#pragma unroll
        for (int jj = 0; jj < 5; ++jj) {
            const int j = w + jj; const bool act = (n > 0) || (j >= 4);
            if (act) {
#pragma unroll
                for (int s = 0; s < 2; ++s) {
                    u32x4 pw; pw.x = cvtpk(S[jj][8 * s + 0], S[jj][8 * s + 1]); pw.y = cvtpk(S[jj][8 * s + 2], S[jj][8 * s + 3]); pw.z = cvtpk(S[jj][8 * s + 4], S[jj][8 * s + 5]); pw.w = cvtpk(S[jj][8 * s + 6], S[jj][8 * s + 7]);
                    const bf16x8 pa = __builtin_bit_cast(bf16x8, pw);
#pragma unroll
                    for (int dh = 0; dh < 2; ++dh) {
                        const LAS unsigned char* vp = vb + (32 * j + 16 * s) * 128 + ((dh * 64) ^ swz);
                        const s16x4 lo = __builtin_bit_cast(s16x4, __builtin_amdgcn_ds_read_tr16_b64_v4i16((LAS v4i16_t*)vp));
                        const s16x4 hi4 = __builtin_bit_cast(s16x4, __builtin_amdgcn_ds_read_tr16_b64_v4i16((LAS v4i16_t*)(vp + 8 * 128)));
                        const bf16x8 vf = (bf16x8){lo[0], lo[1], lo[2], lo[3], hi4[0], hi4[1], hi4[2], hi4[3]};
                        o[dh] = __builtin_amdgcn_mfma_f32_32x32x16_bf16(pa, vf, o[dh], 0, 0, 0);
                    }
                }
            }
        }
    }
    {
        const size_t tq = tok0 + (size_t)lq * DIL;
        const float lse_new = m + __builtin_amdgcn_logf(lsum);
        float a = 0.f, bco = __builtin_amdgcn_rcpf(lsum), lse_out = lse_new;
        if (GB > 0) {
            const float lp = lse_buf[tq * NH + hh];
            const float M = fmaxf(lp, lse_new), wp = __builtin_amdgcn_exp2f(lp - M), wn = __builtin_amdgcn_exp2f(lse_new - M), den = wp + wn, rd = __builtin_amdgcn_rcpf(den);
            a = wp * rd; bco = wn * rd * __builtin_amdgcn_rcpf(lsum); lse_out = M + __builtin_amdgcn_logf(den);
        }
        if (hi == 0) { sc[r32] = a; sc[32 + r32] = bco; if (GB < 2) ST_WT(lse_buf + tq * NH + hh, lse_out); }
        LDS_WAIT();
    }
    unsigned pvv[16];
    if (GB > 0) {
#pragma unroll
        for (int i = 0; i < 16; ++i) { const size_t tq = tok0 + (size_t)(128 * n + 32 * w + crow(i, hi)) * DIL; pvv[i] = *((const unsigned*)(A2 + tq * DM + hh * 64) + r32); }
        asm volatile("s_waitcnt vmcnt(0)" ::: "memory");
    }
#pragma unroll
    for (int i = 0; i < 16; ++i) {
        const int q = crow(i, hi); const float a = sc[q], bco = sc[32 + q];
        const size_t tq = tok0 + (size_t)(128 * n + 32 * w + q) * DIL;
        unsigned* dst = (unsigned*)(A2 + tq * DM + hh * 64) + r32;
        float v0 = o[0][i] * bco, v1 = o[1][i] * bco;
        if (GB > 0) { v0 += a * bflo(pvv[i]); v1 += a * bfhi(pvv[i]); }
        *dst = cvtpk(v0, v1);
    }
    __syncthreads();
}
template <int GB>
__device__ __forceinline__ void attn_branch(Frame& F) { for (int pair = F.vcu; pair < 3072; pair += F.G) attn_pair<GB>(F, pair); }

__device__ __forceinline__ void conv_phase(Frame& F) {
    const int tid_ = opaque_tid(), lane_ = tid_ & 63, wave_ = __builtin_amdgcn_readfirstlane(tid_ >> 6);
    const bf16_t* cvin = (const bf16_t*)(F.ws + WS_CONVIN); bf16_t* A2 = (bf16_t*)(F.ws + WS_XB);
    const int gw = F.vcu * NWAVES + wave_, NGW = F.G * NWAVES, c0 = lane_ * 4;
    float w0[4], w1[4], w2[4];
#pragma unroll
    for (int j = 0; j < 4; ++j) { w0[j] = F.conv_w[c0 + j]; w1[j] = F.conv_w[256 + c0 + j]; w2[j] = F.conv_w[512 + c0 + j]; }
    for (int t = gw; t < NTOK; t += NGW) {
        const int ts = t & (SEQ - 1);
        float y[4] = {0.f, 0.f, 0.f, 0.f};
#pragma unroll
        for (int k = 0; k < 3; ++k) {
            if (ts - 2 + k >= 0) { const bf16_t* row = cvin + (size_t)(t - 2 + k) * 768;
                const u32x2 cx = *(const u32x2*)(row + c0), cc = *(const u32x2*)(row + 512 + c0);
                const float uu[4] = {bflo(cx.x) * bflo(cc.x), bfhi(cx.x) * bfhi(cc.x), bflo(cx.y) * bflo(cc.y), bfhi(cx.y) * bfhi(cc.y)};
#pragma unroll
                for (int j = 0; j < 4; ++j) y[j] += uu[j] * (k == 0 ? w0[j] : k == 1 ? w1[j] : w2[j]); }
        }
        const u32x2 cb = *(const u32x2*)(cvin + (size_t)t * 768 + 256 + c0);
        u32x2 ov; ov.x = cvtpk(bflo(cb.x) * y[0], bfhi(cb.x) * y[1]); ov.y = cvtpk(bflo(cb.y) * y[2], bfhi(cb.y) * y[3]);
        *(u32x2*)(A2 + (size_t)t * DM + 768 + c0) = ov;
    }
}

__device__ __forceinline__ void ln1_phase(Frame& F) {
    const int tid_ = opaque_tid(), lane_ = tid_ & 63, wave_ = __builtin_amdgcn_readfirstlane(tid_ >> 6);
    const bf16_t* z = (const bf16_t*)F.out; bf16_t* x1 = (bf16_t*)(F.ws + WS_XB);
    const int gw = F.vcu * NWAVES + wave_, NGW = F.G * NWAVES;
    f32x4 g[4], bb[4];
#pragma unroll
    for (int j = 0; j < 4; ++j) { g[j] = *(const f32x4*)(F.ln1_g + lane_ * 16 + 4 * j); bb[j] = *(const f32x4*)(F.ln1_b + lane_ * 16 + 4 * j); }
    for (int mrow = gw; mrow < NTOK; mrow += NGW) {
        const u32x4* zr = (const u32x4*)(z + (size_t)mrow * DM) + 2 * lane_; const u32x4 a = __builtin_nontemporal_load(zr), b = __builtin_nontemporal_load(zr + 1);
        float v[16] = {bflo(a.x), bfhi(a.x), bflo(a.y), bfhi(a.y), bflo(a.z), bfhi(a.z), bflo(a.w), bfhi(a.w), bflo(b.x), bfhi(b.x), bflo(b.y), bfhi(b.y), bflo(b.z), bfhi(b.z), bflo(b.w), bfhi(b.w)};
        float s = 0.f;
#pragma unroll
        for (int i = 0; i < 16; ++i) s += v[i];
        const float mean = wave_sum(s) * (1.f / DM); float s2 = 0.f;
#pragma unroll
        for (int i = 0; i < 16; ++i) { v[i] -= mean; s2 += v[i] * v[i]; }
        const float rstd = 1.f / sqrtf(wave_sum(s2) * (1.f / DM) + LN_EPS);
        u32x4 o0, o1;
        { const f32x4 y0 = (f32x4){v[0], v[1], v[2], v[3]} * rstd * g[0] + bb[0], y1 = (f32x4){v[4], v[5], v[6], v[7]} * rstd * g[1] + bb[1];
          const f32x4 y2 = (f32x4){v[8], v[9], v[10], v[11]} * rstd * g[2] + bb[2], y3 = (f32x4){v[12], v[13], v[14], v[15]} * rstd * g[3] + bb[3];
          o0.x = cvtpk(y0.x, y0.y); o0.y = cvtpk(y0.z, y0.w); o0.z = cvtpk(y1.x, y1.y); o0.w = cvtpk(y1.z, y1.w);
          o1.x = cvtpk(y2.x, y2.y); o1.y = cvtpk(y2.z, y2.w); o1.z = cvtpk(y3.x, y3.y); o1.w = cvtpk(y3.z, y3.w); }
        u32x4* xo = (u32x4*)(x1 + (size_t)mrow * DM) + 2 * lane_; xo[0] = o0; xo[1] = o1;
        { u32x4 q;
          const float r = rstd * X_SCALE; const f32x4 gb0 = bb[0] * X_SCALE, gb1 = bb[1] * X_SCALE, gb2 = bb[2] * X_SCALE, gb3 = bb[3] * X_SCALE;
          const f32x4 y0 = (f32x4){v[0], v[1], v[2], v[3]} * r * g[0] + gb0, y1 = (f32x4){v[4], v[5], v[6], v[7]} * r * g[1] + gb1;
          const f32x4 y2 = (f32x4){v[8], v[9], v[10], v[11]} * r * g[2] + gb2, y3 = (f32x4){v[12], v[13], v[14], v[15]} * r * g[3] + gb3;
          int w0 = 0, w1 = 0, w2 = 0, w3 = 0;
          w0 = __builtin_amdgcn_cvt_pk_fp8_f32(y0.x, y0.y, w0, false); w0 = __builtin_amdgcn_cvt_pk_fp8_f32(y0.z, y0.w, w0, true);
          w1 = __builtin_amdgcn_cvt_pk_fp8_f32(y1.x, y1.y, w1, false); w1 = __builtin_amdgcn_cvt_pk_fp8_f32(y1.z, y1.w, w1, true);
          w2 = __builtin_amdgcn_cvt_pk_fp8_f32(y2.x, y2.y, w2, false); w2 = __builtin_amdgcn_cvt_pk_fp8_f32(y2.z, y2.w, w2, true);
          w3 = __builtin_amdgcn_cvt_pk_fp8_f32(y3.x, y3.y, w3, false); w3 = __builtin_amdgcn_cvt_pk_fp8_f32(y3.z, y3.w, w3, true);
          q.x = (unsigned)w0; q.y = (unsigned)w1; q.z = (unsigned)w2; q.w = (unsigned)w3;
          *((u32x4*)(F.ws + WS_X8 + (size_t)mrow * DM) + lane_) = q; }
    }
}

template <int CTRL> __device__ __forceinline__ float dpp_f(float x) { return __builtin_bit_cast(float, __builtin_amdgcn_update_dpp(0, __builtin_bit_cast(int, x), CTRL, 0xf, 0xf, true)); }
__device__ __forceinline__ float wave_max_uniform(float x) {
    x = fmaxf(x, dpp_f<0xB1>(x)); x = fmaxf(x, dpp_f<0x4E>(x)); x = fmaxf(x, dpp_f<0x141>(x)); x = fmaxf(x, dpp_f<0x140>(x));
    const float r0 = __builtin_bit_cast(float, __builtin_amdgcn_readlane(__builtin_bit_cast(int, x), 0)), r1 = __builtin_bit_cast(float, __builtin_amdgcn_readlane(__builtin_bit_cast(int, x), 16));
    const float r2 = __builtin_bit_cast(float, __builtin_amdgcn_readlane(__builtin_bit_cast(int, x), 32)), r3 = __builtin_bit_cast(float, __builtin_amdgcn_readlane(__builtin_bit_cast(int, x), 48));
    return fmaxf(fmaxf(r0, r1), fmaxf(r2, r3));
}
constexpr int CV_ITEMS_E = 384, CV_ITEMS = 257 * CV_ITEMS_E;
struct CvItem { const float* src; unsigned char* dst; int N, ldk; float sc; bool valid; };
__device__ __forceinline__ CvItem cv_decode(const Frame& F, int it, int lane) {
    CvItem c; c.valid = it < CV_ITEMS; if (!c.valid) it = 0;
    const int e = it / CV_ITEMS_E; int r = it % CV_ITEMS_E;
    const float* W; int N, k0, n0, orow; unsigned char* WT;
    if (r < 256) { const bool up = r >= 128; r &= 127; const int kb = r >> 3, nb = r & 7; n0 = 32 * nb; k0 = 64 * kb; N = EDIM;
        W = e < 256 ? (up ? F.eu : F.eg) + (size_t)e * DM * EDIM : (up ? F.su : F.sg); orow = (n0 >> 7) * 256 + (up ? 128 : 0) + (n0 & 127);
        WT = F.ws + WS_W13 + (size_t)e * 512 * DM; c.ldk = DM; c.sc = W13_SCALE; }
    else { r -= 256; const int kb = r >> 5, nb = r & 31; n0 = 32 * nb; k0 = 64 * kb; N = DM;
        W = e < 256 ? F.ed + (size_t)e * EDIM * DM : F.sd; orow = n0;
        WT = F.ws + WS_WD + (size_t)e * DM * EDIM; c.ldk = EDIM; c.sc = WD_SCALE; }
    c.N = N; c.src = W + (size_t)(k0 + (lane >> 5)) * N + n0 + (lane & 31); c.dst = WT + (size_t)orow * c.ldk + k0;
    return c;
}
__device__ __forceinline__ void cv_load(const CvItem& c, float (&r)[32]) {
    if (c.valid) {
#pragma unroll
        for (int i = 0; i < 32; ++i) { const float* p = c.src + (size_t)(2 * i) * c.N; asm volatile("global_load_dword %0, %1, off" : "=v"(r[i]) : "v"(p) : "memory"); }
    }
}
__device__ __forceinline__ void cv_finish(const CvItem& c, const float (&r)[32], LAS float* scr, int lane) {
    if (c.valid) {
#pragma unroll
        for (int i = 0; i < 32; ++i) scr[(2 * i + (lane >> 5)) * 33 + (lane & 31)] = r[i];
        LDS_WAIT(); asm volatile("" ::: "memory");
        const int cc = lane & 3; const float sc = c.sc;
#pragma unroll
        for (int j = 0; j < 2; ++j) { const int n = (lane >> 2) + 16 * j; const volatile LAS float* s = scr + (16 * cc) * 33 + n;
            int w0 = 0, w1 = 0, w2 = 0, w3 = 0;
            w0 = __builtin_amdgcn_cvt_pk_fp8_f32(s[0 * 33] * sc, s[1 * 33] * sc, w0, false); w0 = __builtin_amdgcn_cvt_pk_fp8_f32(s[2 * 33] * sc, s[3 * 33] * sc, w0, true);
            w1 = __builtin_amdgcn_cvt_pk_fp8_f32(s[4 * 33] * sc, s[5 * 33] * sc, w1, false); w1 = __builtin_amdgcn_cvt_pk_fp8_f32(s[6 * 33] * sc, s[7 * 33] * sc, w1, true);
            w2 = __builtin_amdgcn_cvt_pk_fp8_f32(s[8 * 33] * sc, s[9 * 33] * sc, w2, false); w2 = __builtin_amdgcn_cvt_pk_fp8_f32(s[10 * 33] * sc, s[11 * 33] * sc, w2, true);
            w3 = __builtin_amdgcn_cvt_pk_fp8_f32(s[12 * 33] * sc, s[13 * 33] * sc, w3, false); w3 = __builtin_amdgcn_cvt_pk_fp8_f32(s[14 * 33] * sc, s[15 * 33] * sc, w3, true);
            u32x4 o; o.x = (unsigned)w0; o.y = (unsigned)w1; o.z = (unsigned)w2; o.w = (unsigned)w3;
            *(u32x4*)(c.dst + (size_t)n * c.ldk + 16 * cc) = o; }
        LDS_WAIT(); asm volatile("" ::: "memory");
    }
}
__device__ __forceinline__ void route_phase(Frame& F) {
    const int tid_ = opaque_tid(), lane_ = tid_ & 63, wave_ = __builtin_amdgcn_readfirstlane(tid_ >> 6);
    const float* logits = (const float*)(F.ws + WS_LOGIT); int* top_e = (int*)(F.ws + WS_TOPE); float* top_w = (float*)(F.ws + WS_TOPW);
    LAS int* lhist = (LAS int*)(F.lds + 8 * 8448);
    LAS float* scr = (LAS float*)(F.lds + wave_ * 8448);
    const int lane = lane_;
    const int cv_stride = F.G * NWAVES; int cv_next = F.vcu * NWAVES + wave_;
    float rb[4];
#pragma unroll
    for (int j = 0; j < 4; ++j) rb[j] = F.router_bias[lane * 4 + j];
    for (int chunk = F.vcu; chunk < NTOK / 256; chunk += F.G) {
        if (tid_ < 256) lhist[tid_] = 0;
        __syncthreads();
        const f32x4* lgp = (const f32x4*)(logits + (size_t)(chunk * 256 + wave_ * 32) * NEXP) + lane;
        f32x4 lg1 = __builtin_nontemporal_load(lgp), lg2 = __builtin_nontemporal_load(lgp + 64);
#pragma unroll 1
        for (int tt = 0; tt < 32; ++tt) {
            const int t = chunk * 256 + wave_ * 32 + tt;
            asm volatile("s_waitcnt vmcnt(0)" ::: "memory");
            f32x4 lg = lg1; lg1 = lg2; if (tt + 2 < 32) lg2 = __builtin_nontemporal_load(lgp + (tt + 2) * 64);
            asm volatile("" : "+v"(lg), "+v"(lg1));
            __builtin_amdgcn_sched_barrier(0);
            const CvItem ca = cv_decode(F, cv_next, lane), cb = cv_decode(F, cv_next + cv_stride, lane); cv_next += 2 * cv_stride;
            float ra[32], rbuf[32];
            cv_load(ca, ra); cv_load(cb, rbuf);
            __builtin_amdgcn_sched_barrier(0);
            float s[4], v[4];
#pragma unroll
            for (int j = 0; j < 4; ++j) { s[j] = __builtin_amdgcn_rcpf(1.f + __builtin_amdgcn_exp2f(-lg[j] * LOG2E)); v[j] = s[j] + rb[j]; }
            float t1, t2;
            { const float a1 = fmaxf(v[0], v[1]), a2 = fminf(v[0], v[1]), b1 = fmaxf(v[2], v[3]), b2 = fminf(v[2], v[3]); t1 = fmaxf(a1, b1); t2 = fmaxf(fminf(a1, b1), fmaxf(a2, b2)); }
            { const float o1 = dpp_f<0xB1>(t1), o2 = dpp_f<0xB1>(t2); const float n1 = fmaxf(t1, o1), n2 = fmaxf(fminf(t1, o1), fmaxf(t2, o2)); t1 = n1; t2 = n2; }
            { const float o1 = dpp_f<0x4E>(t1), o2 = dpp_f<0x4E>(t2); const float n1 = fmaxf(t1, o1), n2 = fmaxf(fminf(t1, o1), fmaxf(t2, o2)); t1 = n1; t2 = n2; }
            { const float o1 = dpp_f<0x141>(t1), o2 = dpp_f<0x141>(t2); const float n1 = fmaxf(t1, o1), n2 = fmaxf(fminf(t1, o1), fmaxf(t2, o2)); t1 = n1; t2 = n2; }
            const float gs = t1 + t2; const int g = lane >> 3; int rank = 0;
#pragma unroll
            for (int gg = 0; gg < 8; ++gg) { const float og = __builtin_bit_cast(float, __builtin_amdgcn_readlane(__builtin_bit_cast(int, gs), 8 * gg)); rank += (og > gs || (og == gs && gg < g)) ? 1 : 0; }
            if (rank >= 4) { v[0] = -INFINITY; v[1] = -INFINITY; v[2] = -INFINITY; v[3] = -INFINITY; }
            int my_e = 0; float my_s = 0.f, ssum = 0.f;
#pragma unroll
            for (int k = 0; k < 8; ++k) {
                const float mx = wave_max_uniform(fmaxf(fmaxf(v[0], v[1]), fmaxf(v[2], v[3])));
                int best = 1 << 20;
#pragma unroll
                for (int j = 0; j < 4; ++j) { const unsigned long long bal = __ballot(v[j] == mx); const int cand = bal ? (4 * (int)__builtin_ctzll(bal) + j) : (1 << 20); best = cand < best ? cand : best; }
                const int wj = best & 3, wl = best >> 2;
                const float sel = wj == 0 ? s[0] : wj == 1 ? s[1] : wj == 2 ? s[2] : s[3];
                const float sw = __builtin_bit_cast(float, __builtin_amdgcn_readlane(__builtin_bit_cast(int, sel), wl));
                const bool mine = lane == wl;
#pragma unroll
                for (int j = 0; j < 4; ++j) v[j] = (mine && wj == j) ? -INFINITY : v[j];
                my_e = lane == k ? best : my_e; my_s = lane == k ? sw : my_s; ssum += sw;
            }
            if (lane < 8) { top_e[(size_t)t * 8 + lane] = my_e; top_w[(size_t)t * 8 + lane] = my_s / ssum * 2.5f; __hip_atomic_fetch_add(&lhist[my_e], 1, __ATOMIC_RELAXED, __HIP_MEMORY_SCOPE_WORKGROUP); }
            asm volatile("s_waitcnt vmcnt(0)" ::: "memory");
            cv_finish(ca, ra, scr, lane); cv_finish(cb, rbuf, scr, lane);
        }
        __syncthreads();
        if (tid_ < 256) { const int c = lhist[tid_]; if (c) atomicAdd(F.ctl + CW_CNT + tid_, (unsigned)c); }
        __syncthreads();
    }
    for (; cv_next < CV_ITEMS; cv_next += cv_stride) { float r0[32]; const CvItem c = cv_decode(F, cv_next, lane); cv_load(c, r0); asm volatile("s_waitcnt vmcnt(0)" ::: "memory"); cv_finish(c, r0, scr, lane); }
}

__device__ __forceinline__ char* slot_addr(unsigned char* ws, float* out, int s, int t) {
    if (s < 4) return (char*)out + (size_t)t * 4096 + (size_t)s * 1024;
    if (s < 8) return (char*)ws + WS_W13 + (size_t)(s - 4) * 64 * MiB + (size_t)t * 1024;
    return (char*)ws + WS_LOGIT + (size_t)t * 1024;
}

__device__ __forceinline__ void lists_phase(Frame& F) {
    const int tid_ = opaque_tid();
    LAS int* seg_start = (LAS int*)F.lds;
    LAS int* seg_cnt = seg_start + 264;
    LAS int* lhist = seg_cnt + 264;
    LAS int* gbase = lhist + 256;
    const int* top_e = (const int*)(F.ws + WS_TOPE); const float* top_w = (const float*)(F.ws + WS_TOPW);
    int* row_src = (int*)(F.ws + WS_ROWSRC); float* row_w = (float*)(F.ws + WS_ROWW); unsigned long long* row_ptr = (unsigned long long*)(F.ws + WS_ROWPTR); int* panel_e = (int*)(F.ws + WS_PANEL);
    for (int v = tid_; v < NSEG; v += 512) seg_cnt[v] = v == 256 ? NTOK : (int)__hip_atomic_load(F.ctl + CW_CNT + v, __ATOMIC_RELAXED, __HIP_MEMORY_SCOPE_AGENT);
    __syncthreads();
    if (tid_ == 0) { int acc = 0; for (int v = 0; v < NSEG; ++v) { seg_start[v] = acc; acc += (*(volatile LAS int*)(seg_cnt + v) + 255) & ~255; } seg_start[NSEG] = acc;
        if (blockIdx.x == 0) ST_WT(F.ctl + CW_PT, (unsigned)(acc >> 8)); }
    __syncthreads();
    for (int v = F.vcu; v < NSEG; v += F.G) {
        const int s0 = seg_start[v], cnt = seg_cnt[v], s1 = seg_start[v + 1];
        for (int rr = s0 + cnt + tid_; rr < s1; rr += 512) { ST_WT(row_src + rr, 0); ST_WT(row_w + rr, 0.f); ST_WT(row_ptr + rr, (unsigned long long)(F.ws + WS_DUMP + (size_t)(rr & 1023) * 2048)); }
        for (int p = (s0 >> 8) + tid_; p < (s1 >> 8); p += 512) ST_WT(panel_e + p, v);
    }
    for (int i = F.vcu * 512 + tid_; i < NTOK; i += F.G * 512) { const int rr = seg_start[256] + i;
        ST_WT(row_src + rr, i); ST_WT(row_w + rr, SLOT_SCALE); ST_WT(row_ptr + rr, (unsigned long long)slot_addr(F.ws, F.out, 8, i)); }
    for (int chunk = F.vcu; chunk < NTOK / 256; chunk += F.G) {
        if (tid_ < 256) lhist[tid_] = 0;
        __syncthreads();
        int e4[4], lr[4];
#pragma unroll
        for (int k = 0; k < 4; ++k) { const int a = chunk * 2048 + tid_ * 4 + k; e4[k] = top_e[a]; lr[k] = __hip_atomic_fetch_add(&lhist[e4[k]], 1, __ATOMIC_RELAXED, __HIP_MEMORY_SCOPE_WORKGROUP); }
        __syncthreads();
        if (tid_ < 256) { const int c = lhist[tid_]; gbase[tid_] = c ? (int)atomicAdd(F.ctl + CW_CUR + tid_, (unsigned)c) : 0; }
        __syncthreads();
#pragma unroll
        for (int k = 0; k < 4; ++k) { const int a = chunk * 2048 + tid_ * 4 + k, tok = a >> 3, slot = a & 7;
            const int rr = seg_start[e4[k]] + gbase[e4[k]] + lr[k];
            ST_WT(row_src + rr, tok); ST_WT(row_w + rr, top_w[a] * SLOT_SCALE); ST_WT(row_ptr + rr, (unsigned long long)slot_addr(F.ws, F.out, slot, tok)); }
        __syncthreads();
    }
}

constexpr int DN_RING = 0, DN_NSLOT = 6, DN_SLOT = 16384, DN_STG = DN_NSLOT * DN_SLOT, DN_STG_ROW = 80, DN_STG_WAVE = 32 * DN_STG_ROW, DN_TOUCH = DN_STG + 8 * DN_STG_WAVE;
static_assert(DN_TOUCH + 8 * 256 <= MISC_OFF, "down-phase LDS map");
__device__ __forceinline__ int dn_colperm(int s) { return 16 * ((s >> 2) & 1) + (s & 3) + 4 * (s >> 3); }
#define DN_LDSRD(dst, addr, off) asm volatile("ds_read_b128 %0, %1 offset:%2" : "=v"(dst) : "v"(addr), "n"(off))
#define DN_DRAIN(ACC, t, dst) do { _Pragma("unroll") for (int m_ = 2 * (t); m_ < 2 * (t) + 2; ++m_) { const int j_ = m_ >> 1, h_ = m_ & 1; const float x0_ = ACC[4 * j_ + 2 * h_] * rw, x1_ = ACC[4 * j_ + 2 * h_ + 1] * rw; \
            ow[j_] = h_ ? __builtin_amdgcn_cvt_pk_fp8_f32(x0_, x1_, ow[j_], true) : __builtin_amdgcn_cvt_pk_fp8_f32(x0_, x1_, ow[j_], false); asm volatile("" : "+v"(ow[j_])); } \
        if ((t) == 3) { u32x4 o_; o_.x = (unsigned)ow[0]; o_.y = (unsigned)ow[1]; o_.z = (unsigned)ow[2]; o_.w = (unsigned)ow[3]; *(LAS u32x4*)(dst) = o_; } } while (0)
#define DN_MFMA(ACC, t, FIRSTSTEP) do { const i32x8 wa_ = __builtin_shufflevector(__builtin_bit_cast(i32x4, W[2 * (t)]), __builtin_bit_cast(i32x4, W[2 * (t) + 1]), 0, 1, 2, 3, 4, 5, 6, 7); \
        if (FIRSTSTEP) { f32x16 z_; _Pragma("unroll") for (int q_ = 0; q_ < 16; ++q_) z_[q_] = 0.f; \
            ACC = __builtin_amdgcn_mfma_scale_f32_32x32x64_f8f6f4(wa_, __builtin_bit_cast(i32x8, hq[t]), z_, 0, 0, 0, 0x7F7F7F7F, 0, 0x7F7F7F7F); wkeep = wa_; } \
        else ACC = __builtin_amdgcn_mfma_scale_f32_32x32x64_f8f6f4(wa_, __builtin_bit_cast(i32x8, hq[t]), ACC, 0, 0, 0, 0x7F7F7F7F, 0, 0x7F7F7F7F); } while (0)
template <bool FIRST>
__device__ __forceinline__ void dn_chunk(const char* nsrc, f32x16& accA, f32x16& accB, u32x4 (&W)[8], const u32x8 (&hq)[4], LAS unsigned char* lds, unsigned (&a)[8], int& rs,
                                         const float rw, LAS unsigned char* stg_t0, const unsigned stg_ra, GAS char*& gq0, GAS char*& gq1, const unsigned (&dsrc)[2], const int w) {
    {
        int ow[4] = {0, 0, 0, 0}; i32x8 wkeep;
#pragma unroll
        for (int t = 0; t < 4; ++t) {
            asm volatile("s_waitcnt lgkmcnt(6)" : "+v"(W[2 * t]), "+v"(W[2 * t + 1]));
            DN_MFMA(accA, t, t == 0);
            DN_LDSRD(W[2 * t], a[2 * t], 8192); DN_LDSRD(W[2 * t + 1], a[2 * t + 1], 8192);
            if (t == 0) asm volatile("" : "+v"(accA) : "v"(wkeep));
            if (!FIRST) DN_DRAIN(accB, t, stg_t0 + 32);
            __builtin_amdgcn_sched_barrier(0);
        }
    }
    {
        asm volatile("s_waitcnt vmcnt(8) lgkmcnt(0)" : "+v"(W[0]), "+v"(W[1]), "+v"(W[2]), "+v"(W[3]), "+v"(W[4]), "+v"(W[5]), "+v"(W[6]), "+v"(W[7]) :: "memory");
        __builtin_amdgcn_s_barrier(); asm volatile("" ::: "memory");
        LAS unsigned char* const dd = lds + DN_RING + rs * DN_SLOT + 2 * w * 1024;
        const unsigned dl = (unsigned)(rs == DN_NSLOT - 1 ? -(DN_NSLOT - 1) * DN_SLOT : DN_SLOT); rs = rs == DN_NSLOT - 1 ? 0 : rs + 1;
#pragma unroll
        for (int j = 0; j < 8; ++j) a[j] += dl;
        __builtin_amdgcn_sched_barrier(0);
        int ow[4] = {0, 0, 0, 0}; i32x8 wkeep;
        u32x4 fv0 = {0u, 0u, 0u, 0u}, fv1 = {0u, 0u, 0u, 0u};
#pragma unroll
        for (int t = 0; t < 4; ++t) {
            DN_MFMA(accB, t, t == 0);
            DN_LDSRD(W[2 * t], a[2 * t], 0); DN_LDSRD(W[2 * t + 1], a[2 * t + 1], 0);
            if (t == 0) asm volatile("" : "+v"(accB) : "v"(wkeep));
            if (t < 2) __builtin_amdgcn_global_load_lds((const unsigned*)(nsrc + dsrc[t]), (LAS unsigned*)(dd + t * 1024), 16, 0, 0);
            if (!FIRST && t == 0) { DN_LDSRD(fv0, stg_ra, 0); DN_LDSRD(fv1, stg_ra, 16 * DN_STG_ROW); }
            DN_DRAIN(accA, t, stg_t0);
            if (!FIRST && t == 2) { asm volatile("s_waitcnt lgkmcnt(4)" : "+v"(fv0)); *(GAS u32x4*)gq0 = fv0; }
            if (!FIRST && t == 3) { asm volatile("s_waitcnt lgkmcnt(4)" : "+v"(fv1)); *(GAS u32x4*)gq1 = fv1; gq0 += 64; gq1 += 64; }
            __builtin_amdgcn_sched_barrier(0);
        }
    }
}
__device__ __forceinline__ void down_phase(Frame& F, int p0, int np) {
    const int tid_ = opaque_tid(), lane = tid_ & 63, w = __builtin_amdgcn_readfirstlane(tid_ >> 6), r32 = lane & 31, hi = lane >> 5;
    const unsigned char* H = F.ws + WS_H; const char* WD = (const char*)(F.ws + WS_WD);
    const int* panel_e = (const int*)(F.ws + WS_PANEL); const unsigned long long* row_ptr = (const unsigned long long*)(F.ws + WS_ROWPTR); const float* row_w = (const float*)(F.ws + WS_ROWW);
    LAS unsigned char* lds = F.lds;
    LAS unsigned char* stg = lds + DN_STG + w * DN_STG_WAVE;
    LAS unsigned char* stg_t0 = stg + r32 * DN_STG_ROW + 16 * hi;
    const unsigned stg_ra = (unsigned)(size_t)(stg + (lane >> 2) * DN_STG_ROW + (lane & 3) * 16);
    unsigned dsrc[2];
#pragma unroll
    for (int j = 0; j < 2; ++j) { const int sg = 8 * w + 4 * j + (lane >> 4), su = lane & 15, u = su ^ (sg & 15); dsrc[j] = (unsigned)((32 * (sg >> 5) + dn_colperm(sg & 31)) * 256 + u * 16); }
    unsigned a[8];
#pragma unroll
    for (int f = 0; f < 8; ++f) a[f] = (unsigned)(size_t)lds + (unsigned)(DN_RING + r32 * 256 + (((4 * (f >> 1) + 2 * hi + (f & 1)) ^ (r32 & 15)) * 16));
    int p = p0 + F.vcu;
    if (p < p0 + np) {
        int rs = 0;
        const char* Wb = WD + (size_t)__builtin_amdgcn_readfirstlane(panel_e[p]) * (DM * EDIM);
        asm volatile("" ::: "memory"); __builtin_amdgcn_sched_barrier(0);
#pragma unroll
        for (int c = 0; c < DN_NSLOT; ++c)
#pragma unroll
            for (int j = 0; j < 2; ++j) __builtin_amdgcn_global_load_lds((const unsigned*)(Wb + (size_t)c * DN_SLOT + dsrc[j]), (LAS unsigned*)(lds + DN_RING + c * DN_SLOT + (2 * w + j) * 1024), 16, 0, 0);
        __builtin_amdgcn_sched_barrier(0);
        asm volatile("s_waitcnt vmcnt(10)" ::: "memory");
        __builtin_amdgcn_s_barrier(); asm volatile("" ::: "memory");
        u32x4 W[8];
#pragma unroll
        for (int f = 0; f < 8; ++f) DN_LDSRD(W[f], a[f], 0);
        for (;;) {
            const int pn = p + F.G; const bool more = pn < p0 + np;
            const char* Wbn = WD + (size_t)__builtin_amdgcn_readfirstlane(panel_e[more ? pn : p]) * (DM * EDIM);
            const int row0 = p * 256 + 32 * w;
            u32x8 hq[4];
            { const unsigned char* hrow = H + (size_t)(row0 + r32) * EDIM + hi * 32;
#pragma unroll
                for (int t = 0; t < 4; ++t) hq[t] = __builtin_nontemporal_load((const u32x8*)(hrow + 64 * t)); }
            GAS char* gq0 = (GAS char*)row_ptr[row0 + (lane >> 2)] + (lane & 3) * 16;
            GAS char* gq1 = (GAS char*)row_ptr[row0 + 16 + (lane >> 2)] + (lane & 3) * 16;
            const float rw = row_w[row0 + r32] * (1.f / (H_SCALE * WD_SCALE));
            f32x16 accA, accB;
#pragma unroll
            for (int q = 0; q < 16; ++q) { accA[q] = 0.f; accB[q] = 0.f; }
            dn_chunk<true>(Wb + (size_t)DN_NSLOT * DN_SLOT, accA, accB, W, hq, lds, a, rs, rw, stg_t0, stg_ra, gq0, gq1, dsrc, w);
#pragma unroll 1
            for (int c = 1; c < 16; ++c) {
                if (c == 10)
                    __builtin_amdgcn_global_load_lds((const unsigned*)(H + (size_t)((more ? pn : p) * 256 + 32 * w) * EDIM + lane * 128), (LAS unsigned*)(lds + DN_TOUCH + w * 256), 4, 0, 0);
                const char* nsrc = c + DN_NSLOT < 16 ? Wb + (size_t)(c + DN_NSLOT) * DN_SLOT : Wbn + (size_t)(c + DN_NSLOT - 16) * DN_SLOT;
                dn_chunk<false>(nsrc, accA, accB, W, hq, lds, a, rs, rw, stg_t0, stg_ra, gq0, gq1, dsrc, w);
            }
            { u32x4 o;
                { int w0 = 0, w1 = 0, w2 = 0, w3 = 0;
                  w0 = __builtin_amdgcn_cvt_pk_fp8_f32(accB[0] * rw, accB[1] * rw, w0, false); w0 = __builtin_amdgcn_cvt_pk_fp8_f32(accB[2] * rw, accB[3] * rw, w0, true);
                  w1 = __builtin_amdgcn_cvt_pk_fp8_f32(accB[4] * rw, accB[5] * rw, w1, false); w1 = __builtin_amdgcn_cvt_pk_fp8_f32(accB[6] * rw, accB[7] * rw, w1, true);
                  w2 = __builtin_amdgcn_cvt_pk_fp8_f32(accB[8] * rw, accB[9] * rw, w2, false); w2 = __builtin_amdgcn_cvt_pk_fp8_f32(accB[10] * rw, accB[11] * rw, w2, true);
                  w3 = __builtin_amdgcn_cvt_pk_fp8_f32(accB[12] * rw, accB[13] * rw, w3, false); w3 = __builtin_amdgcn_cvt_pk_fp8_f32(accB[14] * rw, accB[15] * rw, w3, true);
                  o.x = (unsigned)w0; o.y = (unsigned)w1; o.z = (unsigned)w2; o.w = (unsigned)w3; }
                *(LAS u32x4*)(stg_t0 + 32) = o;
                u32x4 v0, v1; asm volatile("s_waitcnt lgkmcnt(0)" ::: "memory"); DN_LDSRD(v0, stg_ra, 0); DN_LDSRD(v1, stg_ra, 16 * DN_STG_ROW); asm volatile("s_waitcnt lgkmcnt(0)" : "+v"(v0), "+v"(v1));
                *(GAS u32x4*)gq0 = v0; *(GAS u32x4*)gq1 = v1; }
            if (!more) break;
            p = pn; Wb = Wbn;
        }
    }
    asm volatile("s_waitcnt vmcnt(0) lgkmcnt(0)" ::: "memory");
    __builtin_amdgcn_s_barrier(); asm volatile("" ::: "memory");
}
#undef DN_MFMA
#undef DN_DRAIN
#undef DN_LDSRD

__device__ __forceinline__ void combine_phase(Frame& F) {
    const int tid_ = opaque_tid(), lane_ = tid_ & 63, wave_ = __builtin_amdgcn_readfirstlane(tid_ >> 6);
    const bf16_t* x1 = (const bf16_t*)(F.ws + WS_XB);
    const int gw = F.vcu * NWAVES + wave_, NGW = F.G * NWAVES, lane = lane_;
    f32x4 g[4], bb[4];
#pragma unroll
    for (int j = 0; j < 4; ++j) { g[j] = *(const f32x4*)(F.ln2_g + lane * 16 + 4 * j); bb[j] = *(const f32x4*)(F.ln2_b + lane * 16 + 4 * j); }
    for (int t = gw; t < NTOK; t += NGW) {
        float v[16];
        { const u32x4* xr = (const u32x4*)(x1 + (size_t)t * DM) + 2 * lane; const u32x4 a = __builtin_nontemporal_load(xr), b = __builtin_nontemporal_load(xr + 1);
            v[0] = ALPHA * bflo(a.x); v[1] = ALPHA * bfhi(a.x); v[2] = ALPHA * bflo(a.y); v[3] = ALPHA * bfhi(a.y); v[4] = ALPHA * bflo(a.z); v[5] = ALPHA * bfhi(a.z); v[6] = ALPHA * bflo(a.w); v[7] = ALPHA * bfhi(a.w);
            v[8] = ALPHA * bflo(b.x); v[9] = ALPHA * bfhi(b.x); v[10] = ALPHA * bflo(b.y); v[11] = ALPHA * bfhi(b.y); v[12] = ALPHA * bflo(b.z); v[13] = ALPHA * bfhi(b.z); v[14] = ALPHA * bflo(b.w); v[15] = ALPHA * bfhi(b.w); }
        float f[16];
#pragma unroll
        for (int i = 0; i < 16; ++i) f[i] = 0.f;
#pragma unroll
        for (int s = 0; s < 9; ++s) { const u32x4 q = __builtin_nontemporal_load((const u32x4*)slot_addr(F.ws, F.out, s, t) + lane);
            const unsigned wv[4] = {q.x, q.y, q.z, q.w};
#pragma unroll
            for (int j = 0; j < 4; ++j) { const f32x2_t lo = __builtin_amdgcn_cvt_pk_f32_fp8((int)wv[j], false), hi2 = __builtin_amdgcn_cvt_pk_f32_fp8((int)wv[j], true);
                f[4 * j] += lo.x; f[4 * j + 1] += lo.y; f[4 * j + 2] += hi2.x; f[4 * j + 3] += hi2.y; } }
        float s = 0.f;
#pragma unroll
        for (int i = 0; i < 16; ++i) { v[i] += f[i] * SLOT_INV; s += v[i]; }
        const float mean = wave_sum(s) * (1.f / DM); float s2 = 0.f;
#pragma unroll
        for (int i = 0; i < 16; ++i) { v[i] -= mean; s2 += v[i] * v[i]; }
        const float rstd = 1.f / sqrtf(wave_sum(s2) * (1.f / DM) + LN_EPS);
        float* orow = F.out + (size_t)t * DM + lane * 16;
#pragma unroll
        for (int j = 0; j < 4; ++j) { f32x4 y; y.x = v[4 * j] * rstd; y.y = v[4 * j + 1] * rstd; y.z = v[4 * j + 2] * rstd; y.w = v[4 * j + 3] * rstd;
            *(f32x4*)(orow + 4 * j) = y * g[j] + bb[j]; }
    }
}

struct Args { const float* in[17]; float* out; unsigned char* ws; };
__global__ void __launch_bounds__(NWAVES * 64, 2) fwd_kernel(Args args) {
    extern __shared__ __attribute__((aligned(16))) unsigned char lds[];
    Frame F;
    F.lds = (LAS unsigned char*)lds;
    F.G = gridDim.x; { const int bx = blockIdx.x; F.vcu = (F.G % 8 == 0) ? (bx % 8) * (F.G / 8) + bx / 8 : bx; }
    F.ws = args.ws; F.out = args.out; F.ctl = (unsigned*)(args.ws + WS_CTL);
    F.x = args.in[0]; F.w_in = args.in[1]; F.conv_w = args.in[2]; F.w_o = args.in[3]; F.ln1_g = args.in[4]; F.ln1_b = args.in[5]; F.rel_bias = args.in[6]; F.w_router = args.in[7]; F.router_bias = args.in[8];
    F.eg = args.in[9]; F.eu = args.in[10]; F.ed = args.in[11]; F.sg = args.in[12]; F.su = args.in[13]; F.sd = args.in[14]; F.ln2_g = args.in[15]; F.ln2_b = args.in[16];
    volatile LAS unsigned* MISC = (volatile LAS unsigned*)(F.lds + MISC_OFF);
    for (int u = threadIdx.x; u < (LDS_BYTES - MISC_OFF) / 4; u += NWAVES * 64) MISC[u] = 0u;
    __syncthreads();
    XcdBarrier bar = xcd_barrier_post(F.ctl + CW_BAR, MISC + 8);
    LAS unsigned char* ring = F.lds;

    p0_prologue(F);
    xcd_barrier(bar);
    { DenseOrder S; S.init(NTOK, PROJW, DM / 2, F.G, (int)blockIdx.x, F.ws + WS_WIN); EpiProj E{(bf16_t*)(F.ws + WS_PROJ), (bf16_t*)(F.ws + WS_CONVIN)};
        pg8::gemm_phase<EpiProj, DenseOrder, true, true>(ring, (const char*)(F.ws + WS_XB), DM / 2, S, E); }
    xcd_barrier(bar);
    if (F.G == 256) {
        constexpr int ATT_GPR = 6;
        unsigned* tctr = F.ctl + CW_TEAM + (F.vcu >> 3) * 64; unsigned tgt = 0;
        for (int r0 = 0; r0 < 12; r0 += ATT_GPR) {
            for (int gi = 0; gi < ATT_GPR; ++gi) attn_pair<0>(F, F.vcu + (r0 + gi) * 256);
            tgt += 8; team_barrier(tctr, tgt);
            for (int gi = 0; gi < ATT_GPR; ++gi) attn_pair<1>(F, F.vcu + (r0 + gi) * 256);
            tgt += 8; team_barrier(tctr, tgt);
            for (int gi = 0; gi < ATT_GPR; ++gi) attn_pair<2>(F, F.vcu + (r0 + gi) * 256);
        }
        conv_phase(F);
        xcd_barrier(bar);
    } else {
        { attn_branch<0>(F); conv_phase(F); }
        xcd_barrier(bar);
        attn_branch<1>(F);
        xcd_barrier(bar);
        attn_branch<2>(F);
        xcd_barrier(bar);
    }
    { DenseOrder S; S.init(NTOK, DM, DM, F.G, (int)blockIdx.x, F.ws + WS_WO); EpiWo E{(bf16_t*)F.out, F.x};
        pg8::gemm_phase<EpiWo, DenseOrder, true>(ring, (const char*)(F.ws + WS_XB), DM, S, E); }
    xcd_barrier(bar);
    ln1_phase(F);
    xcd_barrier(bar);
    { DenseOrder S; S.init(NTOK, NEXP, DM, F.G, (int)blockIdx.x, F.ws + WS_WR); EpiF32 E{(float*)(F.ws + WS_LOGIT), NEXP};
        pg8::gemm_phase<EpiF32, DenseOrder, true>(ring, (const char*)(F.ws + WS_XB), DM, S, E); }
    xcd_barrier(bar);
    route_phase(F);
    xcd_barrier(bar);
    lists_phase(F);
    xcd_barrier(bar);
    const int PT = (int)__hip_atomic_load(F.ctl + CW_PT, __ATOMIC_RELAXED, __HIP_MEMORY_SCOPE_AGENT);
    { MoeOrder S{PT * 2, F.G, F.vcu, 1, 0, DM / 2, (const int*)(F.ws + WS_PANEL), (const int*)(F.ws + WS_ROWSRC), (const char*)(F.ws + WS_W13), (size_t)512 * DM};
        EpiGU E{(unsigned char*)(F.ws + WS_H)};
        pg8::gemm_phase<EpiGU, MoeOrder, true, true>(ring, (const char*)(F.ws + WS_X8), DM / 2, S, E); }
    xcd_barrier(bar);
    down_phase(F, 0, PT);
    xcd_barrier(bar);
    combine_phase(F);
}

extern "C" void kernel_launch(void* const* d_in, const int* in_sizes, int n_in, void* d_out, int out_size, void* d_ws, size_t ws_size, hipStream_t stream) {
    static int grid = 0;
    if (grid == 0) {
        if (n_in != 17 || out_size != NTOK * DM || ws_size < WS_NEED) { fprintf(stderr, "kernel_launch: unexpected problem (n_in %d, out %d, ws %zu)\n", n_in, out_size, ws_size); grid = -1; return; }
        int dev = 0, cus = 0;
        if (hipGetDevice(&dev) != hipSuccess || hipDeviceGetAttribute(&cus, hipDeviceAttributeMultiprocessorCount, dev) != hipSuccess) { grid = -1; return; }
        if (hipFuncSetAttribute((const void*)fwd_kernel, hipFuncAttributeMaxDynamicSharedMemorySize, LDS_BYTES) != hipSuccess) { fprintf(stderr, "kernel_launch: hipFuncSetAttribute failed\n"); grid = -1; return; }
        int per_cu = 0;
        if (hipOccupancyMaxActiveBlocksPerMultiprocessor(&per_cu, (const void*)fwd_kernel, NWAVES * 64, LDS_BYTES) != hipSuccess || per_cu < 1) { fprintf(stderr, "kernel_launch: occupancy query reports %d\n", per_cu); }
        (void)hipGetLastError();
        grid = cus;
    }
    if (grid < 0) return;
    (void)hipMemsetAsync((char*)d_ws + WS_CTL, 0, CTL_ZERO_BYTES, stream);
    Args a{};
    for (int i = 0; i < 17; ++i) a.in[i] = (const float*)d_in[i];
    a.out = (float*)d_out; a.ws = (unsigned char*)d_ws;
    hipLaunchKernelGGL(fwd_kernel, dim3(grid), dim3(NWAVES * 64), LDS_BYTES, stream, a);
}
```

```cpp
#include <hip/hip_runtime.h>
#include <cstdio>
#include <cstdint>
#include <cmath>

#define GAS __attribute__((address_space(1)))
#define LAS __attribute__((address_space(3)))
typedef unsigned short bf16_t;
typedef short bf16x8 __attribute__((ext_vector_type(8)));
typedef short s16x4 __attribute__((ext_vector_type(4)));
typedef float f32x4 __attribute__((ext_vector_type(4)));
typedef float f32x16 __attribute__((ext_vector_type(16)));
typedef unsigned u32x4 __attribute__((ext_vector_type(4)));
typedef int i32x8 __attribute__((ext_vector_type(8)));
typedef int i32x4 __attribute__((ext_vector_type(4)));
typedef unsigned u32x8 __attribute__((ext_vector_type(8)));
typedef unsigned u32x2 __attribute__((ext_vector_type(2)));
typedef float f32x2_t __attribute__((ext_vector_type(2)));
typedef __bf16 bf16x2_t __attribute__((ext_vector_type(2)));
typedef short v4i16_t __attribute__((ext_vector_type(4)));

__device__ __forceinline__ unsigned cvtpk(float lo, float hi) { f32x2_t v = {lo, hi}; bf16x2_t b = __builtin_convertvector(v, bf16x2_t); return __builtin_bit_cast(unsigned, b); }
__device__ __forceinline__ float bflo(unsigned u) { return __builtin_bit_cast(float, u << 16); }
__device__ __forceinline__ float bfhi(unsigned u) { return __builtin_bit_cast(float, u & 0xffff0000u); }

__device__ __forceinline__ int opaque_tid() { int t = threadIdx.x; asm volatile("" : "+v"(t)); return t; }
namespace pg8 {
constexpr int BM = 256, BK = 64, HALF = 128, HTB = HALF * BK * 2, STAGE_BYTES = 8 * HTB;
__host__ __device__ __forceinline__ int lds_byte(int r, int c) { const int st = (r >> 4) * 2 + (c >> 5), rr = r & 15, cc = c & 31, ob = rr * 64 + cc * 2; return st * 1024 + (ob ^ (((ob >> 9) & 1) << 5)); }
__host__ __device__ __forceinline__ void stage_rc(int b, int& R, int& C) { const int st = b / 1024, sb = b % 1024, swz = sb ^ (((sb >> 9) & 1) << 5); R = (st >> 1) * 16 + swz / 64; C = (st & 1) * 32 + (swz % 64) / 2; }
__host__ __device__ __forceinline__ int perm32(int rho) { const int n = rho >> 4, i = rho & 15; return 8 * (i >> 2) + 4 * n + (i & 3); }

struct Unit { int pm, pn, aux; };

template <class Epi, class Sched, bool ALIGN_EPI, bool F8 = false>
__device__ __forceinline__ void gemm_phase(LAS unsigned char* lds, const char* Abase, const int K, const Sched& S, const Epi& E) {
    const int tid = opaque_tid(), wid = __builtin_amdgcn_readfirstlane(tid >> 6), lane = tid & 63, wr = wid >> 2, wc = wid & 3, fr = lane & 15, fq = lane >> 4;
    const int nt = K / BK;
    int RA[2], CA[2]; unsigned voffB[2];
#pragma unroll
    for (int i = 0; i < 2; ++i) { int R, C; stage_rc(tid * 16 + i * 8192, R, C); const int Rb = Epi::PERM ? ((R & ~31) + perm32(R & 31)) : R; RA[i] = R; CA[i] = C; voffB[i] = (unsigned)(Rb * K + C) * 2u; }
    const size_t kstep = (size_t)(BK * 2);
    const size_t hstepB = (size_t)HALF * K * 2;
    const unsigned ldsw = (unsigned)wid * 1024u;
    const int aoff = lds_byte(wr * 64 + fr, fq * 8), boff = lds_byte(wc * 32 + fr, fq * 8);
#define PG8_SA(b, h) (((b) * 2 + (h)) * HTB)
#define PG8_SB(b, h) ((4 + (b) * 2 + (h)) * HTB)
#define PG8_STAGE_B(bufoff, gbase) do { _Pragma("unroll") for (int _i = 0; _i < 2; ++_i) \
        __builtin_amdgcn_global_load_lds((const unsigned*)((const char*)(gbase) + voffB[_i]), (LAS unsigned*)(lds + (bufoff) + ldsw + _i * 8192), 16, 0, 0); } while (0)
#define PG8_STAGE_A(bufoff, kptr, vo, h) do { _Pragma("unroll") for (int _i = 0; _i < 2; ++_i) \
        __builtin_amdgcn_global_load_lds((const unsigned*)((const char*)(kptr) + (vo)[h][_i]), (LAS unsigned*)(lds + (bufoff) + ldsw + _i * 8192), 16, 0, 0); } while (0)
#define PG8_LDA(dst, b, h) do { _Pragma("unroll") for (int m = 0; m < 4; ++m) { if constexpr (F8) { const u32x4 lo_ = *(const LAS u32x4*)(lds + PG8_SA(b, h) + aoff + m * 2048), hi_ = *(const LAS u32x4*)(lds + PG8_SA(b, h) + aoff + m * 2048 + 1024); \
            dst##8[m] = __builtin_shufflevector(lo_, hi_, 0, 1, 2, 3, 4, 5, 6, 7); } \
        else { _Pragma("unroll") for (int k = 0; k < 2; ++k) dst[m][k] = *(const LAS bf16x8*)(lds + PG8_SA(b, h) + aoff + m * 2048 + k * 1024); } } } while (0)
#define PG8_LDB(dst, b, h) do { _Pragma("unroll") for (int n = 0; n < 2; ++n) { if constexpr (F8) { const u32x4 lo_ = *(const LAS u32x4*)(lds + PG8_SB(b, h) + boff + n * 2048), hi_ = *(const LAS u32x4*)(lds + PG8_SB(b, h) + boff + n * 2048 + 1024); \
            dst##8[n] = __builtin_shufflevector(lo_, hi_, 0, 1, 2, 3, 4, 5, 6, 7); } \
        else { _Pragma("unroll") for (int k = 0; k < 2; ++k) dst[n][k] = *(const LAS bf16x8*)(lds + PG8_SB(b, h) + boff + n * 2048 + k * 1024); } } } while (0)
#define PG8_MMA(ai, bj, At, Bt) do { __builtin_amdgcn_s_setprio(1); _Pragma("unroll") for (int m = 0; m < 4; ++m) _Pragma("unroll") for (int n = 0; n < 2; ++n) { \
        if constexpr (F8) asm volatile("v_mfma_scale_f32_16x16x128_f8f6f4 %0, %1, %2, %0, %3, %3 op_sel_hi:[0,0,0]" : "+v"(acc[ai][bj][m][n]) : "v"(Bt##8[n]), "v"(At##8[m]), "v"(f8one)); \
        else { _Pragma("unroll") for (int k = 0; k < 2; ++k) acc[ai][bj][m][n] = __builtin_amdgcn_mfma_f32_16x16x32_bf16(Bt[n][k], At[m][k], acc[ai][bj][m][n], 0, 0, 0); } } \
        __builtin_amdgcn_s_setprio(0); } while (0)
#define PG8_WAIT_V(n) asm volatile("s_waitcnt vmcnt(" #n ")" ::: "memory")
#define PG8_WAIT_L(n) asm volatile("s_waitcnt lgkmcnt(" #n ")" ::: "memory")
#define PG8_BAR __builtin_amdgcn_s_barrier()
#define PG8_SCHED __builtin_amdgcn_sched_barrier(0)
    Unit cur, nxt; int ui = 0;
    if (!S.next(0, cur)) return;
    f32x4 acc[2][2][4][2];
#pragma unroll
    for (int a = 0; a < 2; ++a)
#pragma unroll
        for (int b = 0; b < 2; ++b)
#pragma unroll
            for (int m = 0; m < 4; ++m)
#pragma unroll
                for (int n = 0; n < 2; ++n) acc[a][b][m][n] = (f32x4){0.f, 0.f, 0.f, 0.f};
    bf16x8 At[4][2], B0[2][2], B1[2][2];
    u32x8 At8[4], B08[2], B18[2];
    int f8one = 0x7F7F7F7F; asm volatile("" : "+v"(f8one));
    unsigned vc[2][2], vn[2][2];
    S.a_off(cur, RA, CA, vc);
    const char* cB = S.b_base(cur);
    PG8_STAGE_B(PG8_SB(0, 0), cB); PG8_STAGE_B(PG8_SB(0, 1), cB + hstepB); PG8_STAGE_A(PG8_SA(0, 0), Abase, vc, 0); PG8_STAGE_A(PG8_SA(0, 1), Abase, vc, 1);
    if (wr == 1) PG8_BAR;
    PG8_WAIT_V(2); PG8_BAR;
    PG8_STAGE_B(PG8_SB(1, 0), cB + kstep); PG8_STAGE_A(PG8_SA(1, 0), Abase + kstep, vc, 0); PG8_STAGE_B(PG8_SB(1, 1), cB + hstepB + kstep);
    PG8_WAIT_V(6); PG8_BAR;
    for (;;) {
        const bool has_next = S.next(ui + 1, nxt);
        const char* nB = cB;
        if (has_next) { S.a_off(nxt, RA, CA, vn); nB = S.b_base(nxt); }
        else {
#pragma unroll
            for (int h = 0; h < 2; ++h)
#pragma unroll
                for (int i = 0; i < 2; ++i) vn[h][i] = vc[h][i];
        }
#pragma unroll 1
        for (int t = 0; t < nt; t += 2) {
            const bool last = (t == nt - 2);
            const char* ka1 = Abase + (size_t)(t + 1) * kstep;
            const char* ka2 = last ? Abase : Abase + (size_t)(t + 2) * kstep;
            const char* ka3 = ka2 + kstep;
            const char* b2 = last ? nB : cB + (size_t)(t + 2) * kstep;
            const char* b3 = b2 + kstep;
            unsigned v2[2][2];
#pragma unroll
            for (int h = 0; h < 2; ++h)
#pragma unroll
                for (int i = 0; i < 2; ++i) v2[h][i] = last ? vn[h][i] : vc[h][i];
            PG8_LDB(B0, 0, 0); PG8_LDB(B1, 0, 1); PG8_SCHED; PG8_LDA(At, 0, 0); PG8_STAGE_A(PG8_SA(1, 1), ka1, vc, 1);
            PG8_WAIT_V(8); PG8_WAIT_L(0); PG8_BAR; PG8_MMA(0, 0, At, B0); PG8_MMA(0, 1, At, B1); PG8_BAR; PG8_SCHED;
            PG8_LDA(At, 0, 1); PG8_STAGE_B(PG8_SB(0, 0), b2); PG8_STAGE_B(PG8_SB(0, 1), b2 + hstepB); PG8_STAGE_A(PG8_SA(0, 0), ka2, v2, 0);
            PG8_WAIT_V(8); PG8_WAIT_L(0); PG8_BAR; PG8_MMA(1, 0, At, B0); PG8_MMA(1, 1, At, B1); PG8_BAR; PG8_SCHED;
            PG8_LDB(B0, 1, 0); PG8_LDB(B1, 1, 1); PG8_SCHED; PG8_LDA(At, 1, 0); PG8_STAGE_A(PG8_SA(0, 1), ka2, v2, 1);
            PG8_WAIT_V(8); PG8_WAIT_L(0); PG8_BAR; PG8_MMA(0, 0, At, B0); PG8_MMA(0, 1, At, B1); PG8_BAR; PG8_SCHED;
            PG8_LDA(At, 1, 1); PG8_STAGE_B(PG8_SB(1, 0), b3); PG8_STAGE_B(PG8_SB(1, 1), b3 + hstepB); PG8_STAGE_A(PG8_SA(1, 0), ka3, v2, 0);
            PG8_WAIT_V(8); PG8_WAIT_L(0); PG8_BAR; PG8_MMA(1, 0, At, B0); PG8_MMA(1, 1, At, B1); PG8_BAR; PG8_SCHED;
        }
        if constexpr (F8) asm volatile("s_nop 15\n\ts_nop 15" ::: "memory");
        if constexpr (ALIGN_EPI) { if (wr == 0) PG8_BAR; }
        E(acc, cur, wr, wc, fr, fq);
        if (!has_next) break;
#pragma unroll
        for (int a = 0; a < 2; ++a)
#pragma unroll
            for (int b = 0; b < 2; ++b)
#pragma unroll
                for (int m = 0; m < 4; ++m)
#pragma unroll
                    for (int n = 0; n < 2; ++n) acc[a][b][m][n] = (f32x4){0.f, 0.f, 0.f, 0.f};
        cur = nxt; cB = nB; ++ui;
#pragma unroll
        for (int h = 0; h < 2; ++h)
#pragma unroll
            for (int i = 0; i < 2; ++i) vc[h][i] = vn[h][i];
        if constexpr (ALIGN_EPI) { if (wr == 1) PG8_BAR; }
    }
    PG8_WAIT_V(0);
    if constexpr (!ALIGN_EPI) { if (wr == 0) PG8_BAR; }
    PG8_BAR;
#undef PG8_SA
#undef PG8_SB
#undef PG8_STAGE_A
#undef PG8_STAGE_B
#undef PG8_LDA
#undef PG8_LDB
#undef PG8_MMA
#undef PG8_WAIT_V
#undef PG8_WAIT_L
#undef PG8_BAR
#undef PG8_SCHED
}
}

constexpr int DM = 1024, SEQ = 2048, NTOK = 65536, PROJW = 3072, NH = 12, NEXP = 256, EDIM = 256;
constexpr int HALF_TOK = NTOK / 2;
constexpr float SLOT_SCALE = 16.f, SLOT_INV = 1.f / 16.f;
constexpr float X_SCALE = 4.f, W13_SCALE = 16.f;
constexpr float ALPHA = 1.189207115002721f, LN_EPS = 1e-5f, LOG2E = 1.4426950408889634f;
constexpr int NWAVES = 8;

constexpr size_t MiB = (size_t)1 << 20;
constexpr size_t WS_CTL = 0, CTL_ZERO_BYTES = 1 * MiB;
constexpr size_t WS_BIAS = 1 * MiB;
constexpr size_t WS_WIN = 2 * MiB;
constexpr size_t WS_WO = 8 * MiB;
constexpr size_t WS_WR = 10 * MiB;
constexpr size_t WS_W13 = 12 * MiB;
constexpr size_t WS_WD = 269 * MiB;
constexpr size_t WS_XB = 398 * MiB;
constexpr size_t WS_PROJ = 526 * MiB;
constexpr size_t WS_CONVIN = WS_PROJ + 288 * MiB;
constexpr size_t WS_LSE = 910 * MiB;
constexpr size_t WS_LOGIT = 526 * MiB;
constexpr size_t WS_TOPE = 590 * MiB;
constexpr size_t WS_TOPW = 592 * MiB;
constexpr size_t WS_ROWSRC = 594 * MiB;
constexpr size_t WS_ROWW = 597 * MiB;
constexpr size_t WS_H = 600 * MiB;
constexpr size_t WS_ROWPTR = 952 * MiB;
constexpr size_t WS_PANEL = 958 * MiB;
constexpr size_t WS_X8 = 768 * MiB;
constexpr size_t WS_DUMP = 976 * MiB;
constexpr size_t WS_NEED = 1024 * MiB;
constexpr int MAXROWS = NTOK * 8 + 256 * 255 + NTOK;
constexpr int MAXPANELS = MAXROWS / 256;
static_assert((size_t)MAXROWS * 512 <= 320 * MiB && (size_t)MAXROWS * 8 <= 6 * MiB && (size_t)MAXROWS * 4 <= 3 * MiB, "ws map");
constexpr int NSEG = 257;
constexpr int CW_BAR = 4096, CW_CNT = 16384, CW_CUR = 17408, CW_PT = 18433, CW_TEAM = 20480;

constexpr int RING_BYTES = 143360;
constexpr int ATT_HALF = 71680, ATT_K = 0, ATT_V = 36864, ATT_TBL = 69632, ATT_SC = 70400;
constexpr int MISC_OFF = RING_BYTES;
constexpr int LDS_BYTES = 147456;

#define ST_WT(p, v) __hip_atomic_store((p), (v), __ATOMIC_RELAXED, __HIP_MEMORY_SCOPE_AGENT)
#define LDS_WAIT() asm volatile("s_waitcnt lgkmcnt(0)" ::: "memory")
#define VM_WAIT() asm volatile("s_waitcnt vmcnt(0)" ::: "memory")

#define XB_TMO      128
#define XB_XCNT(j)  (256  + 64 * (j))
#define XB_XSUB(j)  (1280 + 64 * (j))
#define XB_XGEN(j)  (2304 + 64 * (j))
#define XB_TOP      3328
#define XB_TOPGEN   3392
#define XCD_BAR_WORDS 3456
#define XB_SPIN_CAP (1u << 18)
__device__ __forceinline__ unsigned xb_ld(unsigned* p)              { return __hip_atomic_load(p, __ATOMIC_RELAXED, __HIP_MEMORY_SCOPE_AGENT); }
__device__ __forceinline__ unsigned xb_add(unsigned* p, unsigned v) { return __hip_atomic_fetch_add(p, v, __ATOMIC_RELAXED, __HIP_MEMORY_SCOPE_AGENT); }
__device__ __forceinline__ unsigned xb_xcc_id() { return (unsigned)__builtin_amdgcn_s_getreg((3 << 11) | 20) & 0xFu; }
#define XB_SPIN(cond, bar) do { unsigned _sp = 0; while (cond) { __builtin_amdgcn_s_sleep(1); \
    if ((++_sp & 255u) == 0u) { if (xb_ld(&(bar)[XB_TMO])) break; if (_sp > XB_SPIN_CAP) { atomicAdd(&(bar)[XB_TMO], 1u); break; } } } } while (0)
struct XcdBarrier { unsigned* bar; unsigned x; volatile LAS unsigned* st; };
__device__ __forceinline__ XcdBarrier xcd_barrier_post(unsigned* bar, volatile LAS unsigned* st) {
    XcdBarrier b; b.bar = bar; b.x = xb_xcc_id(); b.st = st;
    if (threadIdx.x == 0) (void)xb_add(&bar[XB_XCNT(b.x)], 1u);
    return b;
}
__device__ __forceinline__ void xcd_barrier_complete(unsigned* bar, unsigned x, unsigned& nloc, unsigned& nx) {
    const unsigned G = gridDim.x * gridDim.y * gridDim.z;
    unsigned sum, cnt, mine, sp = 0u;
    for (;;) {
        sum = 0u; cnt = 0u; mine = 0u;
#pragma unroll
        for (unsigned j = 0; j < 16; ++j) { const unsigned c = xb_ld(&bar[XB_XCNT(j)]); sum += c; cnt += (c > 0u) ? 1u : 0u; mine = (j == x) ? c : mine; }
        if (sum == G) break;
        __builtin_amdgcn_s_sleep(1);
        if ((++sp & 255u) == 0u) { if (xb_ld(&bar[XB_TMO])) break; if (sp > XB_SPIN_CAP) { atomicAdd(&bar[XB_TMO], 1u); break; } }
    }
    nloc = mine > 0u ? mine : 1u; nx = cnt > 0u ? cnt : 1u;
}
__device__ __forceinline__ void xcd_barrier(const XcdBarrier& b) {
    asm volatile("s_waitcnt vmcnt(0)" ::: "memory");
    __syncthreads();
    if (threadIdx.x == 0) {
        unsigned* bar = b.bar;
        __builtin_amdgcn_s_waitcnt(0);
        unsigned nloc = b.st[0], nx = b.st[1];
        if (nloc == 0u) { xcd_barrier_complete(bar, b.x, nloc, nx); b.st[0] = nloc; b.st[1] = nx; }
        const unsigned old = xb_add(&bar[XB_XSUB(b.x)], 1u);
        const unsigned gen = old / nloc;
        if (old + 1u == (gen + 1u) * nloc) {
            __builtin_amdgcn_fence(__ATOMIC_RELEASE, "agent");
            asm volatile("s_waitcnt vmcnt(0)" ::: "memory");
            const unsigned og = xb_add(&bar[XB_TOP], 1u);
            const unsigned tg = og / nx;
            if (og + 1u == (tg + 1u) * nx) xb_add(&bar[XB_TOPGEN], 1u);
            else XB_SPIN(xb_ld(&bar[XB_TOPGEN]) == tg, bar);
            __builtin_amdgcn_fence(__ATOMIC_ACQUIRE, "agent");
            xb_add(&bar[XB_XGEN(b.x)], 1u);
            asm volatile("s_waitcnt vmcnt(0)" ::: "memory");
        } else {
            XB_SPIN(xb_ld(&bar[XB_XGEN(b.x)]) == gen, bar);
            __builtin_amdgcn_fence(__ATOMIC_ACQUIRE, "agent");
            asm volatile("s_waitcnt vmcnt(0)" ::: "memory");
        }
    }
    __syncthreads();
}

__device__ __forceinline__ void team_barrier(unsigned* ctr, unsigned target) {
    asm volatile("s_waitcnt vmcnt(0)" ::: "memory");
    __syncthreads();
    if (threadIdx.x == 0) {
        __builtin_amdgcn_fence(__ATOMIC_RELEASE, "agent");
        asm volatile("s_waitcnt vmcnt(0)" ::: "memory");
        (void)xb_add(ctr, 1u);
        for (unsigned sp = 0; xb_ld(ctr) < target && sp < (1u << 24); ++sp) __builtin_amdgcn_s_sleep(1);
        __builtin_amdgcn_fence(__ATOMIC_ACQUIRE, "agent");
        asm volatile("s_waitcnt vmcnt(0)" ::: "memory");
    }
    __syncthreads();
}

struct Frame {
    LAS unsigned char* lds;
    unsigned* ctl;
    int vcu, G;
    unsigned char* ws; float* out;
    const float *x, *w_in, *conv_w, *w_o, *ln1_g, *ln1_b, *rel_bias, *w_router, *router_bias, *eg, *eu, *ed, *sg, *su, *sd, *ln2_g, *ln2_b;
};
__device__ __forceinline__ float wave_sum(float v) {
#pragma unroll
    for (int o = 1; o < 64; o <<= 1) v += __shfl_xor(v, o);
    return v;
}

struct DenseOrder {
    int nM, nN, nwg, G, c, K; const char* Bt;
    __device__ __forceinline__ void init(int M, int N, int K_, int G_, int c_, const void* Bt_) { nM = M / 256; nN = N / 256; nwg = nM * nN; G = G_; c = c_; K = K_; Bt = (const char*)Bt_; }
    __device__ __forceinline__ bool next(int i, pg8::Unit& u) const {
        const long L = (long)i * G + c; if (L >= nwg) return false;
        int wgid = (int)L; { const int q = nwg / 8, r = nwg % 8, xcd = wgid % 8, off = wgid / 8; wgid = (xcd < r ? xcd * (q + 1) : r * (q + 1) + (xcd - r) * q) + off; }
        const int nig = 8 * nN, gid = wgid / nig, fm = gid * 8, gsz = (nM - fm) < 8 ? (nM - fm) : 8;
        u.pm = fm + ((wgid % nig) % gsz); u.pn = (wgid % nig) / gsz; u.aux = 0; return true;
    }
    __device__ __forceinline__ void a_off(const pg8::Unit& u, const int (&R)[2], const int (&C)[2], unsigned (&vo)[2][2]) const {
#pragma unroll
        for (int h = 0; h < 2; ++h)
#pragma unroll
            for (int i = 0; i < 2; ++i) vo[h][i] = (unsigned)((u.pm * 256 + 128 * h + R[i]) * K + C[i]) * 2u;
    }
    __device__ __forceinline__ const char* b_base(const pg8::Unit& u) const { return Bt + (size_t)u.pn * 256 * K * 2; }
};
struct MoeOrder {
    int nunits, G, c, shift, p0, K; const int* panel_e; const int* row_src; const char* W; size_t wbytes;
    __device__ __forceinline__ bool next(int i, pg8::Unit& u) const {
        const long L = (long)i * G + c; if (L >= nunits) return false;
        u.pm = p0 + (int)(L >> shift); u.pn = (int)(L & ((1 << shift) - 1)); u.aux = __builtin_amdgcn_readfirstlane(panel_e[u.pm]); return true;
    }
    __device__ __forceinline__ void a_off(const pg8::Unit& u, const int (&R)[2], const int (&C)[2], unsigned (&vo)[2][2]) const {
#pragma unroll
        for (int h = 0; h < 2; ++h)
#pragma unroll
            for (int i = 0; i < 2; ++i) {
                const int row = u.pm * 256 + 128 * h + R[i];
                vo[h][i] = row_src ? ((unsigned)row_src[row] * (unsigned)(K * 2) + (unsigned)C[i] * 2u) : ((unsigned)(row * K + C[i]) * 2u);
            }
    }
    __device__ __forceinline__ const char* b_base(const pg8::Unit& u) const { return W + (size_t)u.aux * wbytes + (size_t)u.pn * 256 * K * 2; }
};

struct EpiProj {
    static constexpr bool PERM = true;
    bf16_t* QKV; bf16_t* CV;
    __device__ __forceinline__ void operator()(const f32x4 (&acc)[2][2][4][2], const pg8::Unit& u, int wr, int wc, int fr, int fq) const {
        const int row0 = u.pm * 256 + wr * 64 + fr;
#pragma unroll
        for (int bj = 0; bj < 2; ++bj) { const int col = u.pn * 256 + bj * 128 + wc * 32 + 8 * fq;
            bf16_t* base; size_t rstride;
            if (col < 2304) { const int which = col / 768, hc = col % 768, h = hc >> 6, d = hc & 63; base = QKV + ((size_t)which * 32 * NH + h) * (SEQ * 64) + d; rstride = 0; }
            else { base = CV + (col - 2304); rstride = 1; }
#pragma unroll
            for (int ai = 0; ai < 2; ++ai)
#pragma unroll
                for (int m = 0; m < 4; ++m) { const int row = row0 + ai * 128 + m * 16; const int b = row >> 11, t = row & (SEQ - 1);
                    bf16_t* p = rstride ? base + (size_t)row * 768 : base + (size_t)b * NH * (SEQ * 64) + (size_t)t * 64;
                    const f32x4 v0 = acc[ai][bj][m][0], v1 = acc[ai][bj][m][1];
                    constexpr float r = 1.f / (X_SCALE * W13_SCALE);
                    u32x4 w; w.x = cvtpk(v0[0] * r, v0[1] * r); w.y = cvtpk(v0[2] * r, v0[3] * r); w.z = cvtpk(v1[0] * r, v1[1] * r); w.w = cvtpk(v1[2] * r, v1[3] * r);
                    *(u32x4*)p = w; }
        }
    }
};
struct EpiF32 {
    static constexpr bool PERM = false;
    float* C; int ldc;
    __device__ __forceinline__ void operator()(const f32x4 (&acc)[2][2][4][2], const pg8::Unit& u, int wr, int wc, int fr, int fq) const {
        const int row0 = u.pm * 256 + wr * 64 + fr, col0 = u.pn * 256 + wc * 32 + 4 * fq;
#pragma unroll
        for (int ai = 0; ai < 2; ++ai)
#pragma unroll
            for (int m = 0; m < 4; ++m) { float* rowp = C + (size_t)(row0 + ai * 128 + m * 16) * ldc + col0;
#pragma unroll
                for (int bj = 0; bj < 2; ++bj)
#pragma unroll
                    for (int n = 0; n < 2; ++n) *(f32x4*)(rowp + bj * 128 + n * 16) = acc[ai][bj][m][n]; }
    }
};
struct EpiWo {
    static constexpr bool PERM = true;
    bf16_t* Z; const float* X;
    __device__ __forceinline__ void operator()(const f32x4 (&acc)[2][2][4][2], const pg8::Unit& u, int wr, int wc, int fr, int fq) const {
        const int row0 = u.pm * 256 + wr * 64 + fr, col0 = u.pn * 256 + wc * 32 + 8 * fq;
#pragma unroll
        for (int ai = 0; ai < 2; ++ai)
#pragma unroll
            for (int m = 0; m < 4; ++m) { const size_t ro = (size_t)(row0 + ai * 128 + m * 16) * DM + col0;
#pragma unroll
                for (int bj = 0; bj < 2; ++bj) { const f32x4 x0 = *(const f32x4*)(X + ro + bj * 128), x1 = *(const f32x4*)(X + ro + bj * 128 + 4);
                    const f32x4 v0 = x0 * ALPHA + acc[ai][bj][m][0], v1 = x1 * ALPHA + acc[ai][bj][m][1];
                    u32x4 w; w.x = cvtpk(v0[0], v0[1]); w.y = cvtpk(v0[2], v0[3]); w.z = cvtpk(v1[0], v1[1]); w.w = cvtpk(v1[2], v1[3]);
                    *(u32x4*)(Z + ro + bj * 128) = w; } }
    }
};
__device__ __forceinline__ float silu_mul(float g, float u) { const float e = __builtin_amdgcn_exp2f(-g * LOG2E); return g * __builtin_amdgcn_rcpf(1.f + e) * u; }
constexpr float H_SCALE = 8.f, WD_SCALE = 8.f;
__device__ __forceinline__ float h8(float g, float u) { constexpr float r = 1.f / (X_SCALE * W13_SCALE); return __builtin_amdgcn_fmed3f(silu_mul(g * r, u * r) * H_SCALE, -448.f, 448.f); }
struct EpiGU {
    static constexpr bool PERM = true;
    unsigned char* H;
    __device__ __forceinline__ void operator()(const f32x4 (&acc)[2][2][4][2], const pg8::Unit& u, int wr, int wc, int fr, int fq) const {
        const int row0 = u.pm * 256 + wr * 64 + fr, col0 = u.pn * 128 + wc * 32 + 8 * fq;
#pragma unroll
        for (int ai = 0; ai < 2; ++ai)
#pragma unroll
            for (int m = 0; m < 4; ++m) { unsigned char* rowp = H + (size_t)(row0 + ai * 128 + m * 16) * EDIM + col0;
                const f32x4 g0 = acc[ai][0][m][0], g1 = acc[ai][0][m][1], u0 = acc[ai][1][m][0], u1 = acc[ai][1][m][1];
                int w0 = 0, w1 = 0;
                w0 = __builtin_amdgcn_cvt_pk_fp8_f32(h8(g0[0], u0[0]), h8(g0[1], u0[1]), w0, false); w0 = __builtin_amdgcn_cvt_pk_fp8_f32(h8(g0[2], u0[2]), h8(g0[3], u0[3]), w0, true);
                w1 = __builtin_amdgcn_cvt_pk_fp8_f32(h8(g1[0], u1[0]), h8(g1[1], u1[1]), w1, false); w1 = __builtin_amdgcn_cvt_pk_fp8_f32(h8(g1[2], u1[2]), h8(g1[3], u1[3]), w1, true);
                u32x2 w; w.x = (unsigned)w0; w.y = (unsigned)w1;
                *(u32x2*)rowp = w; }
    }
};
__device__ __forceinline__ int t5_bucket(int dist) {
    if (dist < 16) return dist;
    int b = 16;
    b += dist >= 22; b += dist >= 30; b += dist >= 40; b += dist >= 54; b += dist >= 73; b += dist >= 99; b += dist >= 134; b += dist >= 182;
    b += dist >= 246; b += dist >= 332; b += dist >= 450; b += dist >= 609; b += dist >= 825; b += dist >= 1117; b += dist >= 1513;
    return b;
}
__device__ __forceinline__ void transpose_item(const float* W, int N, int k0, int n0, bf16_t* WT, int ldk, int out_row0, LAS float* scr, int lane) {
#pragma unroll 8
    for (int i = 0; i < 32; ++i) { const int kk = 2 * i + (lane >> 5); scr[kk * 33 + (lane & 31)] = W[(size_t)(k0 + kk) * N + n0 + (lane & 31)]; }
    LDS_WAIT(); asm volatile("" ::: "memory");
    const int c = lane & 7;
#pragma unroll
    for (int j = 0; j < 4; ++j) { const int n = (lane >> 3) + 8 * j; const LAS float* s = scr + (8 * c) * 33 + n;
        u32x4 o; o.x = cvtpk(s[0 * 33], s[1 * 33]); o.y = cvtpk(s[2 * 33], s[3 * 33]); o.z = cvtpk(s[4 * 33], s[5 * 33]); o.w = cvtpk(s[6 * 33], s[7 * 33]);
        *(u32x4*)(WT + (size_t)(out_row0 + n) * ldk + k0 + 8 * c) = o; }
    LDS_WAIT(); asm volatile("" ::: "memory");
}
__device__ __forceinline__ void transpose_item8(const float* W, int N, int k0, int n0, unsigned char* WT, int ldk, int out_row0, float sc, LAS float* scr, int lane) {
#pragma unroll 8
    for (int i = 0; i < 32; ++i) { const int kk = 2 * i + (lane >> 5); scr[kk * 33 + (lane & 31)] = W[(size_t)(k0 + kk) * N + n0 + (lane & 31)]; }
    LDS_WAIT(); asm volatile("" ::: "memory");
    const int c = lane & 3;
#pragma unroll
    for (int j = 0; j < 2; ++j) { const int n = (lane >> 2) + 16 * j; const LAS float* s = scr + (16 * c) * 33 + n;
        int w0 = 0, w1 = 0, w2 = 0, w3 = 0;
        w0 = __builtin_amdgcn_cvt_pk_fp8_f32(s[0 * 33] * sc, s[1 * 33] * sc, w0, false); w0 = __builtin_amdgcn_cvt_pk_fp8_f32(s[2 * 33] * sc, s[3 * 33] * sc, w0, true);
        w1 = __builtin_amdgcn_cvt_pk_fp8_f32(s[4 * 33] * sc, s[5 * 33] * sc, w1, false); w1 = __builtin_amdgcn_cvt_pk_fp8_f32(s[6 * 33] * sc, s[7 * 33] * sc, w1, true);
        w2 = __builtin_amdgcn_cvt_pk_fp8_f32(s[8 * 33] * sc, s[9 * 33] * sc, w2, false); w2 = __builtin_amdgcn_cvt_pk_fp8_f32(s[10 * 33] * sc, s[11 * 33] * sc, w2, true);
        w3 = __builtin_amdgcn_cvt_pk_fp8_f32(s[12 * 33] * sc, s[13 * 33] * sc, w3, false); w3 = __builtin_amdgcn_cvt_pk_fp8_f32(s[14 * 33] * sc, s[15 * 33] * sc, w3, true);
        u32x4 o; o.x = (unsigned)w0; o.y = (unsigned)w1; o.z = (unsigned)w2; o.w = (unsigned)w3;
        *(u32x4*)(WT + (size_t)(out_row0 + n) * ldk + k0 + 16 * c) = o; }
    LDS_WAIT(); asm volatile("" ::: "memory");
}
__device__ __forceinline__ void p0_prologue(Frame& F) {
    const int tid_ = opaque_tid(), lane_ = tid_ & 63, wave_ = __builtin_amdgcn_readfirstlane(tid_ >> 6);
    LAS float* scr = (LAS float*)(F.lds + wave_ * 8448);
    const int gw = F.vcu * NWAVES + wave_, NGW = F.G * NWAVES, lane = lane_;
    bf16_t* win_t = (bf16_t*)(F.ws + WS_WIN); bf16_t* wo_t = (bf16_t*)(F.ws + WS_WO); bf16_t* wr_t = (bf16_t*)(F.ws + WS_WR);
    unsigned char* w13 = F.ws + WS_W13  ; unsigned char* wd = F.ws + WS_WD;
    constexpr int I_IN = 16 * 96, I_O = 16 * 32, I_R = 16 * 8, I_SMALL = I_IN + I_O + I_R;
    for (int it = gw; it < I_SMALL; it += NGW) {
        int r = it;
        if (r < I_IN) { const int kb = r / 96, nb = r % 96; transpose_item8(F.w_in, PROJW, 64 * kb, 32 * nb, (unsigned char*)win_t, DM, 32 * nb, W13_SCALE, scr, lane); continue; } r -= I_IN;
        if (r < I_O) { const int kb = r / 32, nb = r % 32; transpose_item(F.w_o, DM, 64 * kb, 32 * nb, wo_t, DM, 32 * nb, scr, lane); continue; } r -= I_O;
        { const int kb = r / 8, nb = r % 8; transpose_item(F.w_router, NEXP, 64 * kb, 32 * nb, wr_t, DM, 32 * nb, scr, lane); }
    }
    { float* bt = (float*)(F.ws + WS_BIAS);
      for (int i = F.vcu * 512 + tid_; i < 3 * NH * 192; i += F.G * 512) { const int g = i / (NH * 192), r = i % (NH * 192), h = r / 192, e = r % 192, st = e - 32;
        float v = -INFINITY; if (st >= 0 && st <= 128) v = F.rel_bias[t5_bucket(st << (2 * g)) * NH + h] * LOG2E; bt[i] = v; } }
    { const f32x4* xs = (const f32x4*)F.x; u32x4* xd = (u32x4*)(F.ws + WS_XB); const size_t n16 = (size_t)NTOK * DM / 16, stride = (size_t)F.G * 512;
        for (size_t i = (size_t)F.vcu * 512 + tid_; i < n16; i += stride) { u32x4 o; int wv[4];
#pragma unroll
            for (int j = 0; j < 4; ++j) { const f32x4 a = xs[4 * i + j]; int wj = 0;
                wj = __builtin_amdgcn_cvt_pk_fp8_f32(__builtin_amdgcn_fmed3f(a[0] * X_SCALE, -448.f, 448.f), __builtin_amdgcn_fmed3f(a[1] * X_SCALE, -448.f, 448.f), wj, false);
                wj = __builtin_amdgcn_cvt_pk_fp8_f32(__builtin_amdgcn_fmed3f(a[2] * X_SCALE, -448.f, 448.f), __builtin_amdgcn_fmed3f(a[3] * X_SCALE, -448.f, 448.f), wj, true); wv[j] = wj; }
            o.x = (unsigned)wv[0]; o.y = (unsigned)wv[1]; o.z = (unsigned)wv[2]; o.w = (unsigned)wv[3]; xd[i] = o; } }
}

__device__ __forceinline__ float lane_swap_max(float m) { asm volatile("s_nop 7" : "+v"(m)); auto rr = __builtin_amdgcn_permlane32_swap(__float_as_uint(m), __float_as_uint(m), false, false); unsigned r0 = rr[0], r1 = rr[1]; asm volatile("s_nop 7" : "+v"(r0), "+v"(r1)); return fmaxf(__uint_as_float(r0), __uint_as_float(r1)); }
__device__ __forceinline__ float lane_swap_sum(float m) { asm volatile("s_nop 7" : "+v"(m)); auto rr = __builtin_amdgcn_permlane32_swap(__float_as_uint(m), __float_as_uint(m), false, false); unsigned r0 = rr[0], r1 = rr[1]; asm volatile("s_nop 7" : "+v"(r0), "+v"(r1)); return __uint_as_float(r0) + __uint_as_float(r1); }
__device__ __forceinline__ int crow(int r, int hi) { return (r & 3) + 8 * (r >> 2) + 4 * hi; }

template <int GB>
__device__ __forceinline__ void attn_pair(Frame& F, int pair) {
    const int tid_ = opaque_tid(), lane_ = tid_ & 63, wave_ = __builtin_amdgcn_readfirstlane(tid_ >> 6);
    constexpr int DIL = 1 << (2 * GB), NB = 16 / DIL;
    const int tid = tid_, hw = wave_ >> 2, w = wave_ & 3, ht = tid & 255, lane = lane_, r32 = lane & 31, hi = lane >> 5;
    const int u = pair * 2 + hw;
    const int b = u / 192, rem = u % 192, hh = rem >> 4, blk = rem & 15;
    const int r = blk / NB, n = blk % NB;
    LAS unsigned char* base = F.lds + hw * ATT_HALF;
    LAS unsigned char* Kl = base + ATT_K; LAS unsigned char* Vl = base + ATT_V; LAS float* tbl = (LAS float*)(base + ATT_TBL); LAS float* sc = (LAS float*)(base + ATT_SC + w * 256);
    const bf16_t* proj = (const bf16_t*)(F.ws + WS_PROJ);
    bf16_t* A2 = (bf16_t*)(F.ws + WS_XB); float* lse_buf = (float*)(F.ws + WS_LSE);
    const size_t tok0 = (size_t)b * SEQ + r;
    const bf16_t* qh = proj + ((size_t)(0 * 32 + b) * NH + hh) * (SEQ * 64); const bf16_t* kh = proj + ((size_t)(1 * 32 + b) * NH + hh) * (SEQ * 64); const bf16_t* vh = proj + ((size_t)(2 * 32 + b) * NH + hh) * (SEQ * 64);
    if (ht < 192) tbl[ht] = ((const float*)(F.ws + WS_BIAS))[(GB * NH + hh) * 192 + ht];
    {
        const int c = ht & 7, rb = ht >> 3;
        u32x4 kv[8], vv[8];
#pragma unroll
        for (int it = 0; it < 8; ++it) { const int ki = it * 32 + rb, l = 128 * (n - 1) + ki;
            if (l >= 0) { const size_t ro = (size_t)(l * DIL + r) * 64 + c * 8; kv[it] = *(const u32x4*)(kh + ro); vv[it] = *(const u32x4*)(vh + ro); }
            else { kv[it] = (u32x4){0u, 0u, 0u, 0u}; vv[it] = (u32x4){0u, 0u, 0u, 0u}; } }
#pragma unroll
        for (int it = 0; it < 8; ++it) { const int ki = it * 32 + rb;
            *(LAS u32x4*)(Kl + ki * 144 + c * 16) = kv[it];
            const u32x4 v = vv[it]; const int sw = ((ki >> 1) & 1) * 64;
            u32x2 ev, od; ev.x = (v.x & 0xffffu) | (v.y << 16); ev.y = (v.z & 0xffffu) | (v.w << 16); od.x = (v.x >> 16) | (v.y & 0xffff0000u); od.y = (v.z >> 16) | (v.w & 0xffff0000u);
            *(LAS u32x2*)(Vl + ki * 128 + (0 ^ sw) + c * 8) = ev; *(LAS u32x2*)(Vl + ki * 128 + (64 ^ sw) + c * 8) = od; }
    }
    bf16x8 qf[4];
    const int lq = 128 * n + 32 * w + r32;
    { const bf16_t* qs = qh + (size_t)(lq * DIL + r) * 64 + hi * 8;
#pragma unroll
        for (int ds = 0; ds < 4; ++ds) qf[ds] = *(const bf16x8*)(qs + ds * 16); }
    __syncthreads();
    f32x16 S[5];
    constexpr float SC = 0.125f * LOG2E;
#pragma unroll
    for (int jj = 0; jj < 5; ++jj) {
        const int j = w + jj; const bool act = (n > 0) || (j >= 4);
        if (act) {
            f32x16 a;
#pragma unroll
            for (int i = 0; i < 16; ++i) a[i] = 0.f;
            asm volatile("" : "+v"(a));
            const LAS unsigned char* kp = Kl + (32 * j + r32) * 144 + hi * 16;
#pragma unroll
            for (int ds = 0; ds < 4; ++ds) { const bf16x8 kf = *(const LAS bf16x8*)(kp + ds * 32); a = __builtin_amdgcn_mfma_f32_32x32x16_bf16(kf, qf[ds], a, 0, 0, 0); }
            const int ib = 160 - 32 * jj + r32 - 4 * hi;
#pragma unroll
            for (int i = 0; i < 16; ++i) a[i] = a[i] * SC + *(volatile LAS float*)(tbl + (ib - (i & 3) - 8 * (i >> 2)));
            S[jj] = a;
        } else {
#pragma unroll
            for (int i = 0; i < 16; ++i) S[jj][i] = -INFINITY;
        }
    }
    float m = -INFINITY;
#pragma unroll
    for (int jj = 0; jj < 5; ++jj)
#pragma unroll
        for (int i = 0; i < 16; ++i) m = fmaxf(m, S[jj][i]);
    m = lane_swap_max(m);
    float lsum = 0.f;
#pragma unroll
    for (int jj = 0; jj < 5; ++jj)
#pragma unroll
        for (int i = 0; i < 16; ++i) { const float p = __builtin_amdgcn_exp2f(S[jj][i] - m); S[jj][i] = p; lsum += p; }
    lsum = lane_swap_sum(lsum);
    f32x16 o[2];
#pragma unroll
    for (int i = 0; i < 16; ++i) { o[0][i] = 0.f; o[1][i] = 0.f; }
    asm volatile("" : "+v"(o[0]), "+v"(o[1]));
    { const int q4 = (lane & 15) >> 2, p4 = lane & 3, cb = (lane >> 4) & 1, swz = ((q4 >> 1) & 1) * 64;
        const LAS unsigned char* vb = Vl + (4 * hi + q4) * 128 + cb * 32 + p4 * 8;
#pragma unroll
        for (int jj = 0; jj < 5; ++jj) {
            const int j = w + jj; const bool act = (n > 0) || (j >= 4);
            if (act) {
#pragma unroll
                for (int s = 0; s < 2; ++s) {
                    u32x4 pw; pw.x = cvtpk(S[jj][8 * s + 0], S[jj][8 * s + 1]); pw.y = cvtpk(S[jj][8 * s + 2], S[jj][8 * s + 3]); pw.z = cvtpk(S[jj][8 * s + 4], S[jj][8 * s + 5]); pw.w = cvtpk(S[jj][8 * s + 6], S[jj][8 * s + 7]);
                    const bf16x8 pa = __builtin_bit_cast(bf16x8, pw);
#pragma unroll
                    for (int dh = 0; dh < 2; ++dh) {
                        const LAS unsigned char* vp = vb + (32 * j + 16 * s) * 128 + ((dh * 64) ^ swz);
                        const s16x4 lo = __builtin_bit_cast(s16x4, __builtin_amdgcn_ds_read_tr16_b64_v4i16((LAS v4i16_t*)vp));
                        const s16x4 hi4 = __builtin_bit_cast(s16x4, __builtin_amdgcn_ds_read_tr16_b64_v4i16((LAS v4i16_t*)(vp + 8 * 128)));
                        const bf16x8 vf = (bf16x8){lo[0], lo[1], lo[2], lo[3], hi4[0], hi4[1], hi4[2], hi4[3]};
                        o[dh] = __builtin_amdgcn_mfma_f32_32x32x16_bf16(pa, vf, o[dh], 0, 0, 0);
                    }
                }
            }
        }
    }
    {
        const size_t tq = tok0 + (size_t)lq * DIL;
        const float lse_new = m + __builtin_amdgcn_logf(lsum);
        float a = 0.f, bco = __builtin_amdgcn_rcpf(lsum), lse_out = lse_new;
        if (GB > 0) {
            const float lp = lse_buf[tq * NH + hh];
            const float M = fmaxf(lp, lse_new), wp = __builtin_amdgcn_exp2f(lp - M), wn = __builtin_amdgcn_exp2f(lse_new - M), den = wp + wn, rd = __builtin_amdgcn_rcpf(den);
            a = wp * rd; bco = wn * rd * __builtin_amdgcn_rcpf(lsum); lse_out = M + __builtin_amdgcn_logf(den);
        }
        if (hi == 0) { sc[r32] = a; sc[32 + r32] = bco; if (GB < 2) ST_WT(lse_buf + tq * NH + hh, lse_out); }
        LDS_WAIT();
    }
    unsigned pvv[16];
    if (GB > 0) {
#pragma unroll
        for (int i = 0; i < 16; ++i) { const size_t tq = tok0 + (size_t)(128 * n + 32 * w + crow(i, hi)) * DIL; pvv[i] = *((const unsigned*)(A2 + tq * DM + hh * 64) + r32); }
        asm volatile("s_waitcnt vmcnt(0)" ::: "memory");
    }
#pragma unroll
    for (int i = 0; i < 16; ++i) {
        const int q = crow(i, hi); const float a = sc[q], bco = sc[32 + q];
        const size_t tq = tok0 + (size_t)(128 * n + 32 * w + q) * DIL;
        unsigned* dst = (unsigned*)(A2 + tq * DM + hh * 64) + r32;
        float v0 = o[0][i] * bco, v1 = o[1][i] * bco;
        if (GB > 0) { v0 += a * bflo(pvv[i]); v1 += a * bfhi(pvv[i]); }
        *dst = cvtpk(v0, v1);
    }
    __syncthreads();
}
template <int GB>
__device__ __forceinline__ void attn_branch(Frame& F) { for (int pair = F.vcu; pair < 3072; pair += F.G) attn_pair<GB>(F, pair); }

__device__ __forceinline__ void conv_phase(Frame& F) {
    const int tid_ = opaque_tid(), lane_ = tid_ & 63, wave_ = __builtin_amdgcn_readfirstlane(tid_ >> 6);
    const bf16_t* cvin = (const bf16_t*)(F.ws + WS_CONVIN); bf16_t* A2 = (bf16_t*)(F.ws + WS_XB);
    const int gw = F.vcu * NWAVES + wave_, NGW = F.G * NWAVES, c0 = lane_ * 4;
    float w0[4], w1[4], w2[4];
#pragma unroll
    for (int j = 0; j < 4; ++j) { w0[j] = F.conv_w[c0 + j]; w1[j] = F.conv_w[256 + c0 + j]; w2[j] = F.conv_w[512 + c0 + j]; }
    for (int t = gw; t < NTOK; t += NGW) {
        const int ts = t & (SEQ - 1);
        float y[4] = {0.f, 0.f, 0.f, 0.f};
#pragma unroll
        for (int k = 0; k < 3; ++k) {
            if (ts - 2 + k >= 0) { const bf16_t* row = cvin + (size_t)(t - 2 + k) * 768;
                const u32x2 cx = *(const u32x2*)(row + c0), cc = *(const u32x2*)(row + 512 + c0);
                const float uu[4] = {bflo(cx.x) * bflo(cc.x), bfhi(cx.x) * bfhi(cc.x), bflo(cx.y) * bflo(cc.y), bfhi(cx.y) * bfhi(cc.y)};
#pragma unroll
                for (int j = 0; j < 4; ++j) y[j] += uu[j] * (k == 0 ? w0[j] : k == 1 ? w1[j] : w2[j]); }
        }
        const u32x2 cb = *(const u32x2*)(cvin + (size_t)t * 768 + 256 + c0);
        u32x2 ov; ov.x = cvtpk(bflo(cb.x) * y[0], bfhi(cb.x) * y[1]); ov.y = cvtpk(bflo(cb.y) * y[2], bfhi(cb.y) * y[3]);
        *(u32x2*)(A2 + (size_t)t * DM + 768 + c0) = ov;
    }
}

__device__ __forceinline__ void ln1_phase(Frame& F) {
    const int tid_ = opaque_tid(), lane_ = tid_ & 63, wave_ = __builtin_amdgcn_readfirstlane(tid_ >> 6);
    const bf16_t* z = (const bf16_t*)F.out; bf16_t* x1 = (bf16_t*)(F.ws + WS_XB);
    const int gw = F.vcu * NWAVES + wave_, NGW = F.G * NWAVES;
    f32x4 g[4], bb[4];
#pragma unroll
    for (int j = 0; j < 4; ++j) { g[j] = *(const f32x4*)(F.ln1_g + lane_ * 16 + 4 * j); bb[j] = *(const f32x4*)(F.ln1_b + lane_ * 16 + 4 * j); }
    for (int mrow = gw; mrow < NTOK; mrow += NGW) {
        const u32x4* zr = (const u32x4*)(z + (size_t)mrow * DM) + 2 * lane_; const u32x4 a = zr[0], b = zr[1];
        float v[16] = {bflo(a.x), bfhi(a.x), bflo(a.y), bfhi(a.y), bflo(a.z), bfhi(a.z), bflo(a.w), bfhi(a.w), bflo(b.x), bfhi(b.x), bflo(b.y), bfhi(b.y), bflo(b.z), bfhi(b.z), bflo(b.w), bfhi(b.w)};
        float s = 0.f;
#pragma unroll
        for (int i = 0; i < 16; ++i) s += v[i];
        const float mean = wave_sum(s) * (1.f / DM); float s2 = 0.f;
#pragma unroll
        for (int i = 0; i < 16; ++i) { v[i] -= mean; s2 += v[i] * v[i]; }
        const float rstd = 1.f / sqrtf(wave_sum(s2) * (1.f / DM) + LN_EPS);
        u32x4 o0, o1;
        { const f32x4 y0 = (f32x4){v[0], v[1], v[2], v[3]} * rstd * g[0] + bb[0], y1 = (f32x4){v[4], v[5], v[6], v[7]} * rstd * g[1] + bb[1];
          const f32x4 y2 = (f32x4){v[8], v[9], v[10], v[11]} * rstd * g[2] + bb[2], y3 = (f32x4){v[12], v[13], v[14], v[15]} * rstd * g[3] + bb[3];
          o0.x = cvtpk(y0.x, y0.y); o0.y = cvtpk(y0.z, y0.w); o0.z = cvtpk(y1.x, y1.y); o0.w = cvtpk(y1.z, y1.w);
          o1.x = cvtpk(y2.x, y2.y); o1.y = cvtpk(y2.z, y2.w); o1.z = cvtpk(y3.x, y3.y); o1.w = cvtpk(y3.z, y3.w); }
        u32x4* xo = (u32x4*)(x1 + (size_t)mrow * DM) + 2 * lane_; xo[0] = o0; xo[1] = o1;
        { u32x4 q;
          const float r = rstd * X_SCALE; const f32x4 gb0 = bb[0] * X_SCALE, gb1 = bb[1] * X_SCALE, gb2 = bb[2] * X_SCALE, gb3 = bb[3] * X_SCALE;
          const f32x4 y0 = (f32x4){v[0], v[1], v[2], v[3]} * r * g[0] + gb0, y1 = (f32x4){v[4], v[5], v[6], v[7]} * r * g[1] + gb1;
          const f32x4 y2 = (f32x4){v[8], v[9], v[10], v[11]} * r * g[2] + gb2, y3 = (f32x4){v[12], v[13], v[14], v[15]} * r * g[3] + gb3;
          int w0 = 0, w1 = 0, w2 = 0, w3 = 0;
          w0 = __builtin_amdgcn_cvt_pk_fp8_f32(y0.x, y0.y, w0, false); w0 = __builtin_amdgcn_cvt_pk_fp8_f32(y0.z, y0.w, w0, true);
          w1 = __builtin_amdgcn_cvt_pk_fp8_f32(y1.x, y1.y, w1, false); w1 = __builtin_amdgcn_cvt_pk_fp8_f32(y1.z, y1.w, w1, true);
          w2 = __builtin_amdgcn_cvt_pk_fp8_f32(y2.x, y2.y, w2, false); w2 = __builtin_amdgcn_cvt_pk_fp8_f32(y2.z, y2.w, w2, true);
          w3 = __builtin_amdgcn_cvt_pk_fp8_f32(y3.x, y3.y, w3, false); w3 = __builtin_amdgcn_cvt_pk_fp8_f32(y3.z, y3.w, w3, true);
          q.x = (unsigned)w0; q.y = (unsigned)w1; q.z = (unsigned)w2; q.w = (unsigned)w3;
          *((u32x4*)(F.ws + WS_X8 + (size_t)mrow * DM) + lane_) = q; }
    }
}

template <int CTRL> __device__ __forceinline__ float dpp_f(float x) { return __builtin_bit_cast(float, __builtin_amdgcn_update_dpp(0, __builtin_bit_cast(int, x), CTRL, 0xf, 0xf, true)); }
__device__ __forceinline__ float wave_max_uniform(float x) {
    x = fmaxf(x, dpp_f<0xB1>(x)); x = fmaxf(x, dpp_f<0x4E>(x)); x = fmaxf(x, dpp_f<0x141>(x)); x = fmaxf(x, dpp_f<0x140>(x));
    const float r0 = __builtin_bit_cast(float, __builtin_amdgcn_readlane(__builtin_bit_cast(int, x), 0)), r1 = __builtin_bit_cast(float, __builtin_amdgcn_readlane(__builtin_bit_cast(int, x), 16));
    const float r2 = __builtin_bit_cast(float, __builtin_amdgcn_readlane(__builtin_bit_cast(int, x), 32)), r3 = __builtin_bit_cast(float, __builtin_amdgcn_readlane(__builtin_bit_cast(int, x), 48));
    return fmaxf(fmaxf(r0, r1), fmaxf(r2, r3));
}
constexpr int CV_ITEMS_E = 384, CV_ITEMS = 257 * CV_ITEMS_E;
struct CvItem { const float* src; unsigned char* dst; int N, ldk; float sc; bool valid; };
__device__ __forceinline__ CvItem cv_decode(const Frame& F, int it, int lane) {
    CvItem c; c.valid = it < CV_ITEMS; if (!c.valid) it = 0;
    const int e = it / CV_ITEMS_E; int r = it % CV_ITEMS_E;
    const float* W; int N, k0, n0, orow; unsigned char* WT;
    if (r < 256) { const bool up = r >= 128; r &= 127; const int kb = r >> 3, nb = r & 7; n0 = 32 * nb; k0 = 64 * kb; N = EDIM;
        W = e < 256 ? (up ? F.eu : F.eg) + (size_t)e * DM * EDIM : (up ? F.su : F.sg); orow = (n0 >> 7) * 256 + (up ? 128 : 0) + (n0 & 127);
        WT = F.ws + WS_W13 + (size_t)e * 512 * DM; c.ldk = DM; c.sc = W13_SCALE; }
    else { r -= 256; const int kb = r >> 5, nb = r & 31; n0 = 32 * nb; k0 = 64 * kb; N = DM;
        W = e < 256 ? F.ed + (size_t)e * EDIM * DM : F.sd; orow = n0;
        WT = F.ws + WS_WD + (size_t)e * DM * EDIM; c.ldk = EDIM; c.sc = WD_SCALE; }
    c.N = N; c.src = W + (size_t)(k0 + (lane >> 5)) * N + n0 + (lane & 31); c.dst = WT + (size_t)orow * c.ldk + k0;
    return c;
}
__device__ __forceinline__ void cv_load(const CvItem& c, float (&r)[32]) {
    if (c.valid) {
#pragma unroll
        for (int i = 0; i < 32; ++i) { const float* p = c.src + (size_t)(2 * i) * c.N; asm volatile("global_load_dword %0, %1, off" : "=v"(r[i]) : "v"(p) : "memory"); }
    }
}
__device__ __forceinline__ void cv_finish(const CvItem& c, const float (&r)[32], LAS float* scr, int lane) {
    if (c.valid) {
#pragma unroll
        for (int i = 0; i < 32; ++i) scr[(2 * i + (lane >> 5)) * 33 + (lane & 31)] = r[i];
        LDS_WAIT(); asm volatile("" ::: "memory");
        const int cc = lane & 3; const float sc = c.sc;
#pragma unroll
        for (int j = 0; j < 2; ++j) { const int n = (lane >> 2) + 16 * j; const volatile LAS float* s = scr + (16 * cc) * 33 + n;
            int w0 = 0, w1 = 0, w2 = 0, w3 = 0;
            w0 = __builtin_amdgcn_cvt_pk_fp8_f32(s[0 * 33] * sc, s[1 * 33] * sc, w0, false); w0 = __builtin_amdgcn_cvt_pk_fp8_f32(s[2 * 33] * sc, s[3 * 33] * sc, w0, true);
            w1 = __builtin_amdgcn_cvt_pk_fp8_f32(s[4 * 33] * sc, s[5 * 33] * sc, w1, false); w1 = __builtin_amdgcn_cvt_pk_fp8_f32(s[6 * 33] * sc, s[7 * 33] * sc, w1, true);
            w2 = __builtin_amdgcn_cvt_pk_fp8_f32(s[8 * 33] * sc, s[9 * 33] * sc, w2, false); w2 = __builtin_amdgcn_cvt_pk_fp8_f32(s[10 * 33] * sc, s[11 * 33] * sc, w2, true);
            w3 = __builtin_amdgcn_cvt_pk_fp8_f32(s[12 * 33] * sc, s[13 * 33] * sc, w3, false); w3 = __builtin_amdgcn_cvt_pk_fp8_f32(s[14 * 33] * sc, s[15 * 33] * sc, w3, true);
            u32x4 o; o.x = (unsigned)w0; o.y = (unsigned)w1; o.z = (unsigned)w2; o.w = (unsigned)w3;
            *(u32x4*)(c.dst + (size_t)n * c.ldk + 16 * cc) = o; }
        LDS_WAIT(); asm volatile("" ::: "memory");
    }
}
__device__ __forceinline__ void route_phase(Frame& F) {
    const int tid_ = opaque_tid(), lane_ = tid_ & 63, wave_ = __builtin_amdgcn_readfirstlane(tid_ >> 6);
    const float* logits = (const float*)(F.ws + WS_LOGIT); int* top_e = (int*)(F.ws + WS_TOPE); float* top_w = (float*)(F.ws + WS_TOPW);
    LAS int* lhist = (LAS int*)(F.lds + 8 * 8448);
    LAS float* scr = (LAS float*)(F.lds + wave_ * 8448);
    const int lane = lane_;
    const int cv_stride = F.G * NWAVES; int cv_next = F.vcu * NWAVES + wave_;
    float rb[4];
#pragma unroll
    for (int j = 0; j < 4; ++j) rb[j] = F.router_bias[lane * 4 + j];
    for (int chunk = F.vcu; chunk < NTOK / 256; chunk += F.G) {
        if (tid_ < 256) lhist[tid_] = 0;
        __syncthreads();
        const f32x4* lgp = (const f32x4*)(logits + (size_t)(chunk * 256 + wave_ * 32) * NEXP) + lane;
        f32x4 lg1 = lgp[0], lg2 = lgp[64];
#pragma unroll 1
        for (int tt = 0; tt < 32; ++tt) {
            const int t = chunk * 256 + wave_ * 32 + tt;
            asm volatile("s_waitcnt vmcnt(0)" ::: "memory");
            f32x4 lg = lg1; lg1 = lg2; if (tt + 2 < 32) lg2 = lgp[(tt + 2) * 64];
            asm volatile("" : "+v"(lg), "+v"(lg1));
            __builtin_amdgcn_sched_barrier(0);
            const CvItem ca = cv_decode(F, cv_next, lane), cb = cv_decode(F, cv_next + cv_stride, lane); cv_next += 2 * cv_stride;
            float ra[32], rbuf[32];
            cv_load(ca, ra); cv_load(cb, rbuf);
            __builtin_amdgcn_sched_barrier(0);
            float s[4], v[4];
#pragma unroll
            for (int j = 0; j < 4; ++j) { s[j] = __builtin_amdgcn_rcpf(1.f + __builtin_amdgcn_exp2f(-lg[j] * LOG2E)); v[j] = s[j] + rb[j]; }
            float t1, t2;
            { const float a1 = fmaxf(v[0], v[1]), a2 = fminf(v[0], v[1]), b1 = fmaxf(v[2], v[3]), b2 = fminf(v[2], v[3]); t1 = fmaxf(a1, b1); t2 = fmaxf(fminf(a1, b1), fmaxf(a2, b2)); }
            { const float o1 = dpp_f<0xB1>(t1), o2 = dpp_f<0xB1>(t2); const float n1 = fmaxf(t1, o1), n2 = fmaxf(fminf(t1, o1), fmaxf(t2, o2)); t1 = n1; t2 = n2; }
            { const float o1 = dpp_f<0x4E>(t1), o2 = dpp_f<0x4E>(t2); const float n1 = fmaxf(t1, o1), n2 = fmaxf(fminf(t1, o1), fmaxf(t2, o2)); t1 = n1; t2 = n2; }
            { const float o1 = dpp_f<0x141>(t1), o2 = dpp_f<0x141>(t2); const float n1 = fmaxf(t1, o1), n2 = fmaxf(fminf(t1, o1), fmaxf(t2, o2)); t1 = n1; t2 = n2; }
            const float gs = t1 + t2; const int g = lane >> 3; int rank = 0;
#pragma unroll
            for (int gg = 0; gg < 8; ++gg) { const float og = __builtin_bit_cast(float, __builtin_amdgcn_readlane(__builtin_bit_cast(int, gs), 8 * gg)); rank += (og > gs || (og == gs && gg < g)) ? 1 : 0; }
            if (rank >= 4) { v[0] = -INFINITY; v[1] = -INFINITY; v[2] = -INFINITY; v[3] = -INFINITY; }
            int my_e = 0; float my_s = 0.f, ssum = 0.f;
#pragma unroll
            for (int k = 0; k < 8; ++k) {
                const float mx = wave_max_uniform(fmaxf(fmaxf(v[0], v[1]), fmaxf(v[2], v[3])));
                int best = 1 << 20;
#pragma unroll
                for (int j = 0; j < 4; ++j) { const unsigned long long bal = __ballot(v[j] == mx); const int cand = bal ? (4 * (int)__builtin_ctzll(bal) + j) : (1 << 20); best = cand < best ? cand : best; }
                const int wj = best & 3, wl = best >> 2;
                const float sel = wj == 0 ? s[0] : wj == 1 ? s[1] : wj == 2 ? s[2] : s[3];
                const float sw = __builtin_bit_cast(float, __builtin_amdgcn_readlane(__builtin_bit_cast(int, sel), wl));
                const bool mine = lane == wl;
#pragma unroll
                for (int j = 0; j < 4; ++j) v[j] = (mine && wj == j) ? -INFINITY : v[j];
                my_e = lane == k ? best : my_e; my_s = lane == k ? sw : my_s; ssum += sw;
            }
            if (lane < 8) { top_e[(size_t)t * 8 + lane] = my_e; top_w[(size_t)t * 8 + lane] = my_s / ssum * 2.5f; __hip_atomic_fetch_add(&lhist[my_e], 1, __ATOMIC_RELAXED, __HIP_MEMORY_SCOPE_WORKGROUP); }
            asm volatile("s_waitcnt vmcnt(0)" ::: "memory");
            cv_finish(ca, ra, scr, lane); cv_finish(cb, rbuf, scr, lane);
        }
        __syncthreads();
        if (tid_ < 256) { const int c = lhist[tid_]; if (c) atomicAdd(F.ctl + CW_CNT + tid_, (unsigned)c); }
        __syncthreads();
    }
    for (; cv_next < CV_ITEMS; cv_next += cv_stride) { float r0[32]; const CvItem c = cv_decode(F, cv_next, lane); cv_load(c, r0); asm volatile("s_waitcnt vmcnt(0)" ::: "memory"); cv_finish(c, r0, scr, lane); }
}

__device__ __forceinline__ char* slot_addr(unsigned char* ws, float* out, int s, int t) {
    if (s < 4) return (char*)out + (size_t)t * 4096 + (size_t)s * 1024;
    if (s < 8) return (char*)ws + WS_W13 + (size_t)(s - 4) * 64 * MiB + (size_t)t * 1024;
    return (char*)ws + WS_LOGIT + (size_t)t * 1024;
}

__device__ __forceinline__ void lists_phase(Frame& F) {
    const int tid_ = opaque_tid();
    LAS int* seg_start = (LAS int*)F.lds;
    LAS int* seg_cnt = seg_start + 264;
    LAS int* lhist = seg_cnt + 264;
    LAS int* gbase = lhist + 256;
    const int* top_e = (const int*)(F.ws + WS_TOPE); const float* top_w = (const float*)(F.ws + WS_TOPW);
    int* row_src = (int*)(F.ws + WS_ROWSRC); float* row_w = (float*)(F.ws + WS_ROWW); unsigned long long* row_ptr = (unsigned long long*)(F.ws + WS_ROWPTR); int* panel_e = (int*)(F.ws + WS_PANEL);
    for (int v = tid_; v < NSEG; v += 512) seg_cnt[v] = v == 256 ? NTOK : (int)__hip_atomic_load(F.ctl + CW_CNT + v, __ATOMIC_RELAXED, __HIP_MEMORY_SCOPE_AGENT);
    __syncthreads();
    if (tid_ == 0) { int acc = 0; for (int v = 0; v < NSEG; ++v) { seg_start[v] = acc; acc += (*(volatile LAS int*)(seg_cnt + v) + 255) & ~255; } seg_start[NSEG] = acc;
        if (blockIdx.x == 0) ST_WT(F.ctl + CW_PT, (unsigned)(acc >> 8)); }
    __syncthreads();
    for (int v = F.vcu; v < NSEG; v += F.G) {
        const int s0 = seg_start[v], cnt = seg_cnt[v], s1 = seg_start[v + 1];
        for (int rr = s0 + cnt + tid_; rr < s1; rr += 512) { ST_WT(row_src + rr, 0); ST_WT(row_w + rr, 0.f); ST_WT(row_ptr + rr, (unsigned long long)(F.ws + WS_DUMP + (size_t)(rr & 1023) * 2048)); }
        for (int p = (s0 >> 8) + tid_; p < (s1 >> 8); p += 512) ST_WT(panel_e + p, v);
    }
    for (int i = F.vcu * 512 + tid_; i < NTOK; i += F.G * 512) { const int rr = seg_start[256] + i;
        ST_WT(row_src + rr, i); ST_WT(row_w + rr, SLOT_SCALE); ST_WT(row_ptr + rr, (unsigned long long)slot_addr(F.ws, F.out, 8, i)); }
    for (int chunk = F.vcu; chunk < NTOK / 256; chunk += F.G) {
        if (tid_ < 256) lhist[tid_] = 0;
        __syncthreads();
        int e4[4], lr[4];
#pragma unroll
        for (int k = 0; k < 4; ++k) { const int a = chunk * 2048 + tid_ * 4 + k; e4[k] = top_e[a]; lr[k] = __hip_atomic_fetch_add(&lhist[e4[k]], 1, __ATOMIC_RELAXED, __HIP_MEMORY_SCOPE_WORKGROUP); }
        __syncthreads();
        if (tid_ < 256) { const int c = lhist[tid_]; gbase[tid_] = c ? (int)atomicAdd(F.ctl + CW_CUR + tid_, (unsigned)c) : 0; }
        __syncthreads();
#pragma unroll
        for (int k = 0; k < 4; ++k) { const int a = chunk * 2048 + tid_ * 4 + k, tok = a >> 3, slot = a & 7;
            const int rr = seg_start[e4[k]] + gbase[e4[k]] + lr[k];
            ST_WT(row_src + rr, tok); ST_WT(row_w + rr, top_w[a] * SLOT_SCALE); ST_WT(row_ptr + rr, (unsigned long long)slot_addr(F.ws, F.out, slot, tok)); }
        __syncthreads();
    }
}

constexpr int DN_RING = 0, DN_NSLOT = 6, DN_SLOT = 16384, DN_STG = DN_NSLOT * DN_SLOT, DN_STG_ROW = 80, DN_STG_WAVE = 32 * DN_STG_ROW, DN_TOUCH = DN_STG + 8 * DN_STG_WAVE;
static_assert(DN_TOUCH + 8 * 256 <= MISC_OFF, "down-phase LDS map");
__device__ __forceinline__ int dn_colperm(int s) { return 16 * ((s >> 2) & 1) + (s & 3) + 4 * (s >> 3); }
#define DN_LDSRD(dst, addr, off) asm volatile("ds_read_b128 %0, %1 offset:%2" : "=v"(dst) : "v"(addr), "n"(off))
#define DN_DRAIN(ACC, t, dst) do { _Pragma("unroll") for (int m_ = 2 * (t); m_ < 2 * (t) + 2; ++m_) { const int j_ = m_ >> 1, h_ = m_ & 1; const float x0_ = ACC[4 * j_ + 2 * h_] * rw, x1_ = ACC[4 * j_ + 2 * h_ + 1] * rw; \
            ow[j_] = h_ ? __builtin_amdgcn_cvt_pk_fp8_f32(x0_, x1_, ow[j_], true) : __builtin_amdgcn_cvt_pk_fp8_f32(x0_, x1_, ow[j_], false); asm volatile("" : "+v"(ow[j_])); } \
        if ((t) == 3) { u32x4 o_; o_.x = (unsigned)ow[0]; o_.y = (unsigned)ow[1]; o_.z = (unsigned)ow[2]; o_.w = (unsigned)ow[3]; *(LAS u32x4*)(dst) = o_; } } while (0)
#define DN_MFMA(ACC, t, FIRSTSTEP) do { const i32x8 wa_ = __builtin_shufflevector(__builtin_bit_cast(i32x4, W[2 * (t)]), __builtin_bit_cast(i32x4, W[2 * (t) + 1]), 0, 1, 2, 3, 4, 5, 6, 7); \
        if (FIRSTSTEP) { f32x16 z_; _Pragma("unroll") for (int q_ = 0; q_ < 16; ++q_) z_[q_] = 0.f; \
            ACC = __builtin_amdgcn_mfma_scale_f32_32x32x64_f8f6f4(wa_, __builtin_bit_cast(i32x8, hq[t]), z_, 0, 0, 0, 0x7F7F7F7F, 0, 0x7F7F7F7F); wkeep = wa_; } \
        else ACC = __builtin_amdgcn_mfma_scale_f32_32x32x64_f8f6f4(wa_, __builtin_bit_cast(i32x8, hq[t]), ACC, 0, 0, 0, 0x7F7F7F7F, 0, 0x7F7F7F7F); } while (0)
template <bool FIRST>
__device__ __forceinline__ void dn_chunk(const char* nsrc, f32x16& accA, f32x16& accB, u32x4 (&W)[8], const u32x8 (&hq)[4], LAS unsigned char* lds, unsigned (&a)[8], int& rs,
                                         const float rw, LAS unsigned char* stg_t0, const unsigned stg_ra, GAS char*& gq0, GAS char*& gq1, const bool ok0, const bool ok1, const unsigned (&dsrc)[2], const int w) {
    {
        int ow[4] = {0, 0, 0, 0}; i32x8 wkeep;
#pragma unroll
        for (int t = 0; t < 4; ++t) {
            asm volatile("s_waitcnt lgkmcnt(6)" : "+v"(W[2 * t]), "+v"(W[2 * t + 1]));
            DN_MFMA(accA, t, t == 0);
            DN_LDSRD(W[2 * t], a[2 * t], 8192); DN_LDSRD(W[2 * t + 1], a[2 * t + 1], 8192);
            if (t == 0) asm volatile("" : "+v"(accA) : "v"(wkeep));
            if (!FIRST) DN_DRAIN(accB, t, stg_t0 + 32);
            __builtin_amdgcn_sched_barrier(0);
        }
    }
    {
        asm volatile("s_waitcnt vmcnt(8) lgkmcnt(0)" : "+v"(W[0]), "+v"(W[1]), "+v"(W[2]), "+v"(W[3]), "+v"(W[4]), "+v"(W[5]), "+v"(W[6]), "+v"(W[7]) :: "memory");
        __builtin_amdgcn_s_barrier(); asm volatile("" ::: "memory");
        LAS unsigned char* const dd = lds + DN_RING + rs * DN_SLOT + 2 * w * 1024;
        const unsigned dl = (unsigned)(rs == DN_NSLOT - 1 ? -(DN_NSLOT - 1) * DN_SLOT : DN_SLOT); rs = rs == DN_NSLOT - 1 ? 0 : rs + 1;
#pragma unroll
        for (int j = 0; j < 8; ++j) a[j] += dl;
        __builtin_amdgcn_sched_barrier(0);
        int ow[4] = {0, 0, 0, 0}; i32x8 wkeep;
        u32x4 fv0 = {0u, 0u, 0u, 0u}, fv1 = {0u, 0u, 0u, 0u};
#pragma unroll
        for (int t = 0; t < 4; ++t) {
            DN_MFMA(accB, t, t == 0);
            DN_LDSRD(W[2 * t], a[2 * t], 0); DN_LDSRD(W[2 * t + 1], a[2 * t + 1], 0);
            if (t == 0) asm volatile("" : "+v"(accB) : "v"(wkeep));
            if (t < 2) __builtin_amdgcn_global_load_lds((const unsigned*)(nsrc + dsrc[t]), (LAS unsigned*)(dd + t * 1024), 16, 0, 0);
            if (!FIRST && t == 0) { DN_LDSRD(fv0, stg_ra, 0); DN_LDSRD(fv1, stg_ra, 16 * DN_STG_ROW); }
            DN_DRAIN(accA, t, stg_t0);
            if (!FIRST && t == 2) { asm volatile("s_waitcnt lgkmcnt(4)" : "+v"(fv0)); if (ok0) *(GAS u32x4*)gq0 = fv0; }
            if (!FIRST && t == 3) { asm volatile("s_waitcnt lgkmcnt(4)" : "+v"(fv1)); if (ok1) *(GAS u32x4*)gq1 = fv1; gq0 += 64; gq1 += 64; }
            __builtin_amdgcn_sched_barrier(0);
        }
    }
}
__device__ __forceinline__ void down_phase(Frame& F, int p0, int np) {
    const int tid_ = opaque_tid(), lane = tid_ & 63, w = __builtin_amdgcn_readfirstlane(tid_ >> 6), r32 = lane & 31, hi = lane >> 5;
    const unsigned char* H = F.ws + WS_H; const char* WD = (const char*)(F.ws + WS_WD);
    const int* panel_e = (const int*)(F.ws + WS_PANEL); const unsigned long long* row_ptr = (const unsigned long long*)(F.ws + WS_ROWPTR); const float* row_w = (const float*)(F.ws + WS_ROWW);
    LAS unsigned char* lds = F.lds;
    LAS unsigned char* stg = lds + DN_STG + w * DN_STG_WAVE;
    LAS unsigned char* stg_t0 = stg + r32 * DN_STG_ROW + 16 * hi;
    const unsigned stg_ra = (unsigned)(size_t)(stg + (lane >> 2) * DN_STG_ROW + (lane & 3) * 16);
    unsigned dsrc[2];
#pragma unroll
    for (int j = 0; j < 2; ++j) { const int sg = 8 * w + 4 * j + (lane >> 4), su = lane & 15, u = su ^ (sg & 15); dsrc[j] = (unsigned)((32 * (sg >> 5) + dn_colperm(sg & 31)) * 256 + u * 16); }
    unsigned a[8];
#pragma unroll
    for (int f = 0; f < 8; ++f) a[f] = (unsigned)(size_t)lds + (unsigned)(DN_RING + r32 * 256 + (((4 * (f >> 1) + 2 * hi + (f & 1)) ^ (r32 & 15)) * 16));
    int p = p0 + F.vcu;
    if (p < p0 + np) {
        int rs = 0;
        const char* Wb = WD + (size_t)__builtin_amdgcn_readfirstlane(panel_e[p]) * (DM * EDIM);
        asm volatile("" ::: "memory"); __builtin_amdgcn_sched_barrier(0);
#pragma unroll
        for (int c = 0; c < DN_NSLOT; ++c)
#pragma unroll
            for (int j = 0; j < 2; ++j) __builtin_amdgcn_global_load_lds((const unsigned*)(Wb + (size_t)c * DN_SLOT + dsrc[j]), (LAS unsigned*)(lds + DN_RING + c * DN_SLOT + (2 * w + j) * 1024), 16, 0, 0);
        __builtin_amdgcn_sched_barrier(0);
        asm volatile("s_waitcnt vmcnt(10)" ::: "memory");
        __builtin_amdgcn_s_barrier(); asm volatile("" ::: "memory");
        u32x4 W[8];
#pragma unroll
        for (int f = 0; f < 8; ++f) DN_LDSRD(W[f], a[f], 0);
        for (;;) {
            const int pn = p + F.G; const bool more = pn < p0 + np;
            const char* Wbn = WD + (size_t)__builtin_amdgcn_readfirstlane(panel_e[more ? pn : p]) * (DM * EDIM);
            const int row0 = p * 256 + 32 * w;
            u32x8 hq[4];
            { const unsigned char* hrow = H + (size_t)(row0 + r32) * EDIM + hi * 32;
#pragma unroll
                for (int t = 0; t < 4; ++t) hq[t] = *(const u32x8*)(hrow + 64 * t); }
            GAS char* gq0 = (GAS char*)row_ptr[row0 + (lane >> 2)] + (lane & 3) * 16;
            GAS char* gq1 = (GAS char*)row_ptr[row0 + 16 + (lane >> 2)] + (lane & 3) * 16;
            const float rw = row_w[row0 + r32] * (1.f / (H_SCALE * WD_SCALE));
            const bool ok0 = (size_t)((const unsigned char*)gq0 - (F.ws + WS_DUMP)) >= (size_t)(2 * MiB), ok1 = (size_t)((const unsigned char*)gq1 - (F.ws + WS_DUMP)) >= (size_t)(2 * MiB);
            f32x16 accA, accB;
#pragma unroll
            for (int q = 0; q < 16; ++q) { accA[q] = 0.f; accB[q] = 0.f; }
            dn_chunk<true>(Wb + (size_t)DN_NSLOT * DN_SLOT, accA, accB, W, hq, lds, a, rs, rw, stg_t0, stg_ra, gq0, gq1, ok0, ok1, dsrc, w);
#pragma unroll 1
            for (int c = 1; c < 16; ++c) {
                if (c == 10)
                    __builtin_amdgcn_global_load_lds((const unsigned*)(H + (size_t)((more ? pn : p) * 256 + 32 * w) * EDIM + lane * 128), (LAS unsigned*)(lds + DN_TOUCH + w * 256), 4, 0, 0);
                const char* nsrc = c + DN_NSLOT < 16 ? Wb + (size_t)(c + DN_NSLOT) * DN_SLOT : Wbn + (size_t)(c + DN_NSLOT - 16) * DN_SLOT;
                dn_chunk<false>(nsrc, accA, accB, W, hq, lds, a, rs, rw, stg_t0, stg_ra, gq0, gq1, ok0, ok1, dsrc, w);
            }
            { u32x4 o;
                { int w0 = 0, w1 = 0, w2 = 0, w3 = 0;
                  w0 = __builtin_amdgcn_cvt_pk_fp8_f32(accB[0] * rw, accB[1] * rw, w0, false); w0 = __builtin_amdgcn_cvt_pk_fp8_f32(accB[2] * rw, accB[3] * rw, w0, true);
                  w1 = __builtin_amdgcn_cvt_pk_fp8_f32(accB[4] * rw, accB[5] * rw, w1, false); w1 = __builtin_amdgcn_cvt_pk_fp8_f32(accB[6] * rw, accB[7] * rw, w1, true);
                  w2 = __builtin_amdgcn_cvt_pk_fp8_f32(accB[8] * rw, accB[9] * rw, w2, false); w2 = __builtin_amdgcn_cvt_pk_fp8_f32(accB[10] * rw, accB[11] * rw, w2, true);
                  w3 = __builtin_amdgcn_cvt_pk_fp8_f32(accB[12] * rw, accB[13] * rw, w3, false); w3 = __builtin_amdgcn_cvt_pk_fp8_f32(accB[14] * rw, accB[15] * rw, w3, true);
                  o.x = (unsigned)w0; o.y = (unsigned)w1; o.z = (unsigned)w2; o.w = (unsigned)w3; }
                *(LAS u32x4*)(stg_t0 + 32) = o;
                u32x4 v0, v1; asm volatile("s_waitcnt lgkmcnt(0)" ::: "memory"); DN_LDSRD(v0, stg_ra, 0); DN_LDSRD(v1, stg_ra, 16 * DN_STG_ROW); asm volatile("s_waitcnt lgkmcnt(0)" : "+v"(v0), "+v"(v1));
                if (ok0) *(GAS u32x4*)gq0 = v0; if (ok1) *(GAS u32x4*)gq1 = v1; }
            if (!more) break;
            p = pn; Wb = Wbn;
        }
    }
    asm volatile("s_waitcnt vmcnt(0) lgkmcnt(0)" ::: "memory");
    __builtin_amdgcn_s_barrier(); asm volatile("" ::: "memory");
}
#undef DN_MFMA
#undef DN_DRAIN
#undef DN_LDSRD

__device__ __forceinline__ void combine_phase(Frame& F) {
    const int tid_ = opaque_tid(), lane_ = tid_ & 63, wave_ = __builtin_amdgcn_readfirstlane(tid_ >> 6);
    const bf16_t* x1 = (const bf16_t*)(F.ws + WS_XB);
    const int gw = F.vcu * NWAVES + wave_, NGW = F.G * NWAVES, lane = lane_;
    f32x4 g[4], bb[4];
#pragma unroll
    for (int j = 0; j < 4; ++j) { g[j] = *(const f32x4*)(F.ln2_g + lane * 16 + 4 * j); bb[j] = *(const f32x4*)(F.ln2_b + lane * 16 + 4 * j); }
    for (int t = gw; t < NTOK; t += NGW) {
        float v[16];
        { const u32x4* xr = (const u32x4*)(x1 + (size_t)t * DM) + 2 * lane; const u32x4 a = xr[0], b = xr[1];
            v[0] = ALPHA * bflo(a.x); v[1] = ALPHA * bfhi(a.x); v[2] = ALPHA * bflo(a.y); v[3] = ALPHA * bfhi(a.y); v[4] = ALPHA * bflo(a.z); v[5] = ALPHA * bfhi(a.z); v[6] = ALPHA * bflo(a.w); v[7] = ALPHA * bfhi(a.w);
            v[8] = ALPHA * bflo(b.x); v[9] = ALPHA * bfhi(b.x); v[10] = ALPHA * bflo(b.y); v[11] = ALPHA * bfhi(b.y); v[12] = ALPHA * bflo(b.z); v[13] = ALPHA * bfhi(b.z); v[14] = ALPHA * bflo(b.w); v[15] = ALPHA * bfhi(b.w); }
        float f[16];
#pragma unroll
        for (int i = 0; i < 16; ++i) f[i] = 0.f;
#pragma unroll
        for (int s = 0; s < 9; ++s) { const u32x4 q = __builtin_nontemporal_load((const u32x4*)slot_addr(F.ws, F.out, s, t) + lane);
            const unsigned wv[4] = {q.x, q.y, q.z, q.w};
#pragma unroll
            for (int j = 0; j < 4; ++j) { const f32x2_t lo = __builtin_amdgcn_cvt_pk_f32_fp8((int)wv[j], false), hi2 = __builtin_amdgcn_cvt_pk_f32_fp8((int)wv[j], true);
                f[4 * j] += lo.x; f[4 * j + 1] += lo.y; f[4 * j + 2] += hi2.x; f[4 * j + 3] += hi2.y; } }
        float s = 0.f;
#pragma unroll
        for (int i = 0; i < 16; ++i) { v[i] += f[i] * SLOT_INV; s += v[i]; }
        const float mean = wave_sum(s) * (1.f / DM); float s2 = 0.f;
#pragma unroll
        for (int i = 0; i < 16; ++i) { v[i] -= mean; s2 += v[i] * v[i]; }
        const float rstd = 1.f / sqrtf(wave_sum(s2) * (1.f / DM) + LN_EPS);
        float* orow = F.out + (size_t)t * DM + lane * 16;
#pragma unroll
        for (int j = 0; j < 4; ++j) { f32x4 y; y.x = v[4 * j] * rstd; y.y = v[4 * j + 1] * rstd; y.z = v[4 * j + 2] * rstd; y.w = v[4 * j + 3] * rstd;
            *(f32x4*)(orow + 4 * j) = y * g[j] + bb[j]; }
    }
}

struct Args { const float* in[17]; float* out; unsigned char* ws; };
__global__ void __launch_bounds__(NWAVES * 64, 2) fwd_kernel(Args args) {
    extern __shared__ __attribute__((aligned(16))) unsigned char lds[];
    Frame F;
    F.lds = (LAS unsigned char*)lds;
    F.G = gridDim.x; { const int bx = blockIdx.x; F.vcu = (F.G % 8 == 0) ? (bx % 8) * (F.G / 8) + bx / 8 : bx; }
    F.ws = args.ws; F.out = args.out; F.ctl = (unsigned*)(args.ws + WS_CTL);
    F.x = args.in[0]; F.w_in = args.in[1]; F.conv_w = args.in[2]; F.w_o = args.in[3]; F.ln1_g = args.in[4]; F.ln1_b = args.in[5]; F.rel_bias = args.in[6]; F.w_router = args.in[7]; F.router_bias = args.in[8];
    F.eg = args.in[9]; F.eu = args.in[10]; F.ed = args.in[11]; F.sg = args.in[12]; F.su = args.in[13]; F.sd = args.in[14]; F.ln2_g = args.in[15]; F.ln2_b = args.in[16];
    volatile LAS unsigned* MISC = (volatile LAS unsigned*)(F.lds + MISC_OFF);
    for (int u = threadIdx.x; u < (LDS_BYTES - MISC_OFF) / 4; u += NWAVES * 64) MISC[u] = 0u;
    __syncthreads();
    XcdBarrier bar = xcd_barrier_post(F.ctl + CW_BAR, MISC + 8);
    LAS unsigned char* ring = F.lds;

    p0_prologue(F);
    xcd_barrier(bar);
    { DenseOrder S; S.init(NTOK, PROJW, DM / 2, F.G, (int)blockIdx.x, F.ws + WS_WIN); EpiProj E{(bf16_t*)(F.ws + WS_PROJ), (bf16_t*)(F.ws + WS_CONVIN)};
        pg8::gemm_phase<EpiProj, DenseOrder, true, true>(ring, (const char*)(F.ws + WS_XB), DM / 2, S, E); }
    xcd_barrier(bar);
    if (F.G == 256) {
        constexpr int ATT_GPR = 6;
        unsigned* tctr = F.ctl + CW_TEAM + (F.vcu >> 3) * 64; unsigned tgt = 0;
        for (int r0 = 0; r0 < 12; r0 += ATT_GPR) {
            for (int gi = 0; gi < ATT_GPR; ++gi) attn_pair<0>(F, F.vcu + (r0 + gi) * 256);
            tgt += 8; team_barrier(tctr, tgt);
            for (int gi = 0; gi < ATT_GPR; ++gi) attn_pair<1>(F, F.vcu + (r0 + gi) * 256);
            tgt += 8; team_barrier(tctr, tgt);
            for (int gi = 0; gi < ATT_GPR; ++gi) attn_pair<2>(F, F.vcu + (r0 + gi) * 256);
        }
        conv_phase(F);
        xcd_barrier(bar);
    } else {
        { attn_branch<0>(F); conv_phase(F); }
        xcd_barrier(bar);
        attn_branch<1>(F);
        xcd_barrier(bar);
        attn_branch<2>(F);
        xcd_barrier(bar);
    }
    { DenseOrder S; S.init(NTOK, DM, DM, F.G, (int)blockIdx.x, F.ws + WS_WO); EpiWo E{(bf16_t*)F.out, F.x};
        pg8::gemm_phase<EpiWo, DenseOrder, true>(ring, (const char*)(F.ws + WS_XB), DM, S, E); }
    xcd_barrier(bar);
    ln1_phase(F);
    xcd_barrier(bar);
    { DenseOrder S; S.init(NTOK, NEXP, DM, F.G, (int)blockIdx.x, F.ws + WS_WR); EpiF32 E{(float*)(F.ws + WS_LOGIT), NEXP};
        pg8::gemm_phase<EpiF32, DenseOrder, true>(ring, (const char*)(F.ws + WS_XB), DM, S, E); }
    xcd_barrier(bar);
    route_phase(F);
    xcd_barrier(bar);
    lists_phase(F);
    xcd_barrier(bar);
    const int PT = (int)__hip_atomic_load(F.ctl + CW_PT, __ATOMIC_RELAXED, __HIP_MEMORY_SCOPE_AGENT);
    { MoeOrder S{PT * 2, F.G, F.vcu, 1, 0, DM / 2, (const int*)(F.ws + WS_PANEL), (const int*)(F.ws + WS_ROWSRC), (const char*)(F.ws + WS_W13), (size_t)512 * DM};
        EpiGU E{(unsigned char*)(F.ws + WS_H)};
        pg8::gemm_phase<EpiGU, MoeOrder, true, true>(ring, (const char*)(F.ws + WS_X8), DM / 2, S, E); }
    xcd_barrier(bar);
    down_phase(F, 0, PT);
    xcd_barrier(bar);
    combine_phase(F);
}

extern "C" void kernel_launch(void* const* d_in, const int* in_sizes, int n_in, void* d_out, int out_size, void* d_ws, size_t ws_size, hipStream_t stream) {
    static int grid = 0;
    if (grid == 0) {
        if (n_in != 17 || out_size != NTOK * DM || ws_size < WS_NEED) { fprintf(stderr, "kernel_launch: unexpected problem (n_in %d, out %d, ws %zu)\n", n_in, out_size, ws_size); grid = -1; return; }
        int dev = 0, cus = 0;
        if (hipGetDevice(&dev) != hipSuccess || hipDeviceGetAttribute(&cus, hipDeviceAttributeMultiprocessorCount, dev) != hipSuccess) { grid = -1; return; }
        if (hipFuncSetAttribute((const void*)fwd_kernel, hipFuncAttributeMaxDynamicSharedMemorySize, LDS_BYTES) != hipSuccess) { fprintf(stderr, "kernel_launch: hipFuncSetAttribute failed\n"); grid = -1; return; }
        int per_cu = 0;
        if (hipOccupancyMaxActiveBlocksPerMultiprocessor(&per_cu, (const void*)fwd_kernel, NWAVES * 64, LDS_BYTES) != hipSuccess || per_cu < 1) { fprintf(stderr, "kernel_launch: occupancy query reports %d\n", per_cu); }
        (void)hipGetLastError();
        grid = cus;
    }
    if (grid < 0) return;
    (void)hipMemsetAsync((char*)d_ws + WS_CTL, 0, CTL_ZERO_BYTES, stream);
    Args a{};
    for (int i = 0; i < 17; ++i) a.in[i] = (const float*)d_in[i];
    a.out = (float*)d_out; a.ws = (unsigned char*)d_ws;
    hipLaunchKernelGGL(fwd_kernel, dim3(grid), dim3(NWAVES * 64), LDS_BYTES, stream, a);
}
```

```cpp
#include <hip/hip_runtime.h>
#include <cstdio>
#include <cstdint>
#include <cmath>

#define GAS __attribute__((address_space(1)))
#define LAS __attribute__((address_space(3)))
typedef unsigned short bf16_t;
typedef short bf16x8 __attribute__((ext_vector_type(8)));
typedef short s16x4 __attribute__((ext_vector_type(4)));
typedef float f32x4 __attribute__((ext_vector_type(4)));
typedef float f32x16 __attribute__((ext_vector_type(16)));
typedef unsigned u32x4 __attribute__((ext_vector_type(4)));
typedef int i32x8 __attribute__((ext_vector_type(8)));
typedef int i32x4 __attribute__((ext_vector_type(4)));
typedef unsigned u32x8 __attribute__((ext_vector_type(8)));
typedef unsigned u32x2 __attribute__((ext_vector_type(2)));
typedef float f32x2_t __attribute__((ext_vector_type(2)));
typedef __bf16 bf16x2_t __attribute__((ext_vector_type(2)));
typedef short v4i16_t __attribute__((ext_vector_type(4)));

__device__ __forceinline__ unsigned cvtpk(float lo, float hi) { f32x2_t v = {lo, hi}; bf16x2_t b = __builtin_convertvector(v, bf16x2_t); return __builtin_bit_cast(unsigned, b); }
__device__ __forceinline__ float bflo(unsigned u) { return __builtin_bit_cast(float, u << 16); }
__device__ __forceinline__ float bfhi(unsigned u) { return __builtin_bit_cast(float, u & 0xffff0000u); }

__device__ __forceinline__ int opaque_tid() { int t = threadIdx.x; asm volatile("" : "+v"(t)); return t; }
namespace pg8 {
constexpr int BM = 256, BK = 64, HALF = 128, HTB = HALF * BK * 2, STAGE_BYTES = 8 * HTB;
__host__ __device__ __forceinline__ int lds_byte(int r, int c) { const int st = (r >> 4) * 2 + (c >> 5), rr = r & 15, cc = c & 31, ob = rr * 64 + cc * 2; return st * 1024 + (ob ^ (((ob >> 9) & 1) << 5)); }
__host__ __device__ __forceinline__ void stage_rc(int b, int& R, int& C) { const int st = b / 1024, sb = b % 1024, swz = sb ^ (((sb >> 9) & 1) << 5); R = (st >> 1) * 16 + swz / 64; C = (st & 1) * 32 + (swz % 64) / 2; }
__host__ __device__ __forceinline__ int perm32(int rho) { const int n = rho >> 4, i = rho & 15; return 8 * (i >> 2) + 4 * n + (i & 3); }

struct Unit { int pm, pn, aux; };

template <class Epi, class Sched, bool ALIGN_EPI, bool F8 = false>
__device__ __forceinline__ void gemm_phase(LAS unsigned char* lds, const char* Abase, const int K, const Sched& S, const Epi& E) {
    const int tid = opaque_tid(), wid = __builtin_amdgcn_readfirstlane(tid >> 6), lane = tid & 63, wr = wid >> 2, wc = wid & 3, fr = lane & 15, fq = lane >> 4;
    const int nt = K / BK;
    int RA[2], CA[2]; unsigned voffB[2];
#pragma unroll
    for (int i = 0; i < 2; ++i) { int R, C; stage_rc(tid * 16 + i * 8192, R, C); const int Rb = Epi::PERM ? ((R & ~31) + perm32(R & 31)) : R; RA[i] = R; CA[i] = C; voffB[i] = (unsigned)(Rb * K + C) * 2u; }
    const size_t kstep = (size_t)(BK * 2);
    const size_t hstepB = (size_t)HALF * K * 2;
    const unsigned ldsw = (unsigned)wid * 1024u;
    const int aoff = lds_byte(wr * 64 + fr, fq * 8), boff = lds_byte(wc * 32 + fr, fq * 8);
#define PG8_SA(b, h) (((b) * 2 + (h)) * HTB)
#define PG8_SB(b, h) ((4 + (b) * 2 + (h)) * HTB)
#define PG8_STAGE_B(bufoff, gbase) do { _Pragma("unroll") for (int _i = 0; _i < 2; ++_i) \
        __builtin_amdgcn_global_load_lds((const unsigned*)((const char*)(gbase) + voffB[_i]), (LAS unsigned*)(lds + (bufoff) + ldsw + _i * 8192), 16, 0, 0); } while (0)
#define PG8_STAGE_A(bufoff, kptr, vo, h) do { _Pragma("unroll") for (int _i = 0; _i < 2; ++_i) \
        __builtin_amdgcn_global_load_lds((const unsigned*)((const char*)(kptr) + (vo)[h][_i]), (LAS unsigned*)(lds + (bufoff) + ldsw + _i * 8192), 16, 0, 0); } while (0)
#define PG8_LDA(dst, b, h) do { _Pragma("unroll") for (int m = 0; m < 4; ++m) { if constexpr (F8) { const u32x4 lo_ = *(const LAS u32x4*)(lds + PG8_SA(b, h) + aoff + m * 2048), hi_ = *(const LAS u32x4*)(lds + PG8_SA(b, h) + aoff + m * 2048 + 1024); \
            dst##8[m] = __builtin_shufflevector(lo_, hi_, 0, 1, 2, 3, 4, 5, 6, 7); } \
        else { _Pragma("unroll") for (int k = 0; k < 2; ++k) dst[m][k] = *(const LAS bf16x8*)(lds + PG8_SA(b, h) + aoff + m * 2048 + k * 1024); } } } while (0)
#define PG8_LDB(dst, b, h) do { _Pragma("unroll") for (int n = 0; n < 2; ++n) { if constexpr (F8) { const u32x4 lo_ = *(const LAS u32x4*)(lds + PG8_SB(b, h) + boff + n * 2048), hi_ = *(const LAS u32x4*)(lds + PG8_SB(b, h) + boff + n * 2048 + 1024); \
            dst##8[n] = __builtin_shufflevector(lo_, hi_, 0, 1, 2, 3, 4, 5, 6, 7); } \
        else { _Pragma("unroll") for (int k = 0; k < 2; ++k) dst[n][k] = *(const LAS bf16x8*)(lds + PG8_SB(b, h) + boff + n * 2048 + k * 1024); } } } while (0)
#define PG8_MMA(ai, bj, At, Bt) do { __builtin_amdgcn_s_setprio(1); _Pragma("unroll") for (int m = 0; m < 4; ++m) _Pragma("unroll") for (int n = 0; n < 2; ++n) { \
        if constexpr (F8) asm volatile("v_mfma_scale_f32_16x16x128_f8f6f4 %0, %1, %2, %0, %3, %3 op_sel_hi:[0,0,0]" : "+v"(acc[ai][bj][m][n]) : "v"(Bt##8[n]), "v"(At##8[m]), "v"(f8one)); \
        else { _Pragma("unroll") for (int k = 0; k < 2; ++k) acc[ai][bj][m][n] = __builtin_amdgcn_mfma_f32_16x16x32_bf16(Bt[n][k], At[m][k], acc[ai][bj][m][n], 0, 0, 0); } } \
        __builtin_amdgcn_s_setprio(0); } while (0)
#define PG8_WAIT_V(n) asm volatile("s_waitcnt vmcnt(" #n ")" ::: "memory")
#define PG8_WAIT_L(n) asm volatile("s_waitcnt lgkmcnt(" #n ")" ::: "memory")
#define PG8_BAR __builtin_amdgcn_s_barrier()
#define PG8_SCHED __builtin_amdgcn_sched_barrier(0)
    Unit cur, nxt; int ui = 0;
    if (!S.next(0, cur)) return;
    f32x4 acc[2][2][4][2];
#pragma unroll
    for (int a = 0; a < 2; ++a)
#pragma unroll
        for (int b = 0; b < 2; ++b)
#pragma unroll
            for (int m = 0; m < 4; ++m)
#pragma unroll
                for (int n = 0; n < 2; ++n) acc[a][b][m][n] = (f32x4){0.f, 0.f, 0.f, 0.f};
    bf16x8 At[4][2], B0[2][2], B1[2][2];
    u32x8 At8[4], B08[2], B18[2];
    int f8one = 0x7F7F7F7F; asm volatile("" : "+v"(f8one));
    unsigned vc[2][2], vn[2][2];
    S.a_off(cur, RA, CA, vc);
    const char* cB = S.b_base(cur);
    PG8_STAGE_B(PG8_SB(0, 0), cB); PG8_STAGE_B(PG8_SB(0, 1), cB + hstepB); PG8_STAGE_A(PG8_SA(0, 0), Abase, vc, 0); PG8_STAGE_A(PG8_SA(0, 1), Abase, vc, 1);
    if (wr == 1) PG8_BAR;
    PG8_WAIT_V(2); PG8_BAR;
    PG8_STAGE_B(PG8_SB(1, 0), cB + kstep); PG8_STAGE_A(PG8_SA(1, 0), Abase + kstep, vc, 0); PG8_STAGE_B(PG8_SB(1, 1), cB + hstepB + kstep);
    PG8_WAIT_V(6); PG8_BAR;
    for (;;) {
        const bool has_next = S.next(ui + 1, nxt);
        const char* nB = cB;
        if (has_next) { S.a_off(nxt, RA, CA, vn); nB = S.b_base(nxt); }
        else {
#pragma unroll
            for (int h = 0; h < 2; ++h)
#pragma unroll
                for (int i = 0; i < 2; ++i) vn[h][i] = vc[h][i];
        }
#pragma unroll 1
        for (int t = 0; t < nt; t += 2) {
            const bool last = (t == nt - 2);
            const char* ka1 = Abase + (size_t)(t + 1) * kstep;
            const char* ka2 = last ? Abase : Abase + (size_t)(t + 2) * kstep;
            const char* ka3 = ka2 + kstep;
            const char* b2 = last ? nB : cB + (size_t)(t + 2) * kstep;
            const char* b3 = b2 + kstep;
            unsigned v2[2][2];
#pragma unroll
            for (int h = 0; h < 2; ++h)
#pragma unroll
                for (int i = 0; i < 2; ++i) v2[h][i] = last ? vn[h][i] : vc[h][i];
            PG8_LDB(B0, 0, 0); PG8_LDB(B1, 0, 1); PG8_SCHED; PG8_LDA(At, 0, 0); PG8_STAGE_A(PG8_SA(1, 1), ka1, vc, 1);
            PG8_WAIT_V(8); PG8_WAIT_L(0); PG8_BAR; PG8_MMA(0, 0, At, B0); PG8_MMA(0, 1, At, B1); PG8_BAR; PG8_SCHED;
            PG8_LDA(At, 0, 1); PG8_STAGE_B(PG8_SB(0, 0), b2); PG8_STAGE_B(PG8_SB(0, 1), b2 + hstepB); PG8_STAGE_A(PG8_SA(0, 0), ka2, v2, 0);
            PG8_WAIT_V(8); PG8_WAIT_L(0); PG8_BAR; PG8_MMA(1, 0, At, B0); PG8_MMA(1, 1, At, B1); PG8_BAR; PG8_SCHED;
            PG8_LDB(B0, 1, 0); PG8_LDB(B1, 1, 1); PG8_SCHED; PG8_LDA(At, 1, 0); PG8_STAGE_A(PG8_SA(0, 1), ka2, v2, 1);
            PG8_WAIT_V(8); PG8_WAIT_L(0); PG8_BAR; PG8_MMA(0, 0, At, B0); PG8_MMA(0, 1, At, B1); PG8_BAR; PG8_SCHED;
            PG8_LDA(At, 1, 1); PG8_STAGE_B(PG8_SB(1, 0), b3); PG8_STAGE_B(PG8_SB(1, 1), b3 + hstepB); PG8_STAGE_A(PG8_SA(1, 0), ka3, v2, 0);
            PG8_WAIT_V(8); PG8_WAIT_L(0); PG8_BAR; PG8_MMA(1, 0, At, B0); PG8_MMA(1, 1, At, B1); PG8_BAR; PG8_SCHED;
        }
        if constexpr (F8) asm volatile("s_nop 15\n\ts_nop 15" ::: "memory");
        if constexpr (ALIGN_EPI) { if (wr == 0) PG8_BAR; }
        E(acc, cur, wr, wc, fr, fq);
        if (!has_next) break;
#pragma unroll
        for (int a = 0; a < 2; ++a)
#pragma unroll
            for (int b = 0; b < 2; ++b)
#pragma unroll
                for (int m = 0; m < 4; ++m)
#pragma unroll
                    for (int n = 0; n < 2; ++n) acc[a][b][m][n] = (f32x4){0.f, 0.f, 0.f, 0.f};
        cur = nxt; cB = nB; ++ui;
#pragma unroll
        for (int h = 0; h < 2; ++h)
#pragma unroll
            for (int i = 0; i < 2; ++i) vc[h][i] = vn[h][i];
        if constexpr (ALIGN_EPI) { if (wr == 1) PG8_BAR; }
    }
    PG8_WAIT_V(0);
    if constexpr (!ALIGN_EPI) { if (wr == 0) PG8_BAR; }
    PG8_BAR;
#undef PG8_SA
#undef PG8_SB
#undef PG8_STAGE_A
#undef PG8_STAGE_B
#undef PG8_LDA
#undef PG8_LDB
#undef PG8_MMA
#undef PG8_WAIT_V
#undef PG8_WAIT_L
#undef PG8_BAR
#undef PG8_SCHED
}
}

constexpr int DM = 1024, SEQ = 2048, NTOK = 65536, PROJW = 3072, NH = 12, NEXP = 256, EDIM = 256;
constexpr int HALF_TOK = NTOK / 2;
constexpr float SLOT_SCALE = 16.f, SLOT_INV = 1.f / 16.f;
constexpr float X_SCALE = 4.f, W13_SCALE = 16.f;
constexpr float ALPHA = 1.189207115002721f, LN_EPS = 1e-5f, LOG2E = 1.4426950408889634f;
constexpr int NWAVES = 8;

constexpr size_t MiB = (size_t)1 << 20;
constexpr size_t WS_CTL = 0, CTL_ZERO_BYTES = 1 * MiB;
constexpr size_t WS_BIAS = 1 * MiB;
constexpr size_t WS_WIN = 2 * MiB;
constexpr size_t WS_WO = 8 * MiB;
constexpr size_t WS_WR = 10 * MiB;
constexpr size_t WS_W13 = 12 * MiB;
constexpr size_t WS_WD = 269 * MiB;
constexpr size_t WS_XB = 398 * MiB;
constexpr size_t WS_PROJ = 526 * MiB;
constexpr size_t WS_CONVIN = WS_PROJ + 288 * MiB;
constexpr size_t WS_LSE = 910 * MiB;
constexpr size_t WS_LOGIT = 526 * MiB;
constexpr size_t WS_TOPE = 590 * MiB;
constexpr size_t WS_TOPW = 592 * MiB;
constexpr size_t WS_ROWSRC = 594 * MiB;
constexpr size_t WS_ROWW = 597 * MiB;
constexpr size_t WS_H = 600 * MiB;
constexpr size_t WS_ROWPTR = 952 * MiB;
constexpr size_t WS_PANEL = 958 * MiB;
constexpr size_t WS_X8 = 768 * MiB;
constexpr size_t WS_DUMP = 976 * MiB;
constexpr size_t WS_NEED = 1024 * MiB;
constexpr int MAXROWS = NTOK * 8 + 256 * 255 + NTOK;
constexpr int MAXPANELS = MAXROWS / 256;
static_assert((size_t)MAXROWS * 512 <= 320 * MiB && (size_t)MAXROWS * 8 <= 6 * MiB && (size_t)MAXROWS * 4 <= 3 * MiB, "ws map");
constexpr int NSEG = 257;
constexpr int CW_BAR = 4096, CW_CNT = 16384, CW_CUR = 17408, CW_PT = 18433, CW_TEAM = 20480;

constexpr int RING_BYTES = 143360;
constexpr int ATT_HALF = 71680, ATT_K = 0, ATT_V = 36864, ATT_TBL = 69632, ATT_SC = 70400;
constexpr int MISC_OFF = RING_BYTES;
constexpr int LDS_BYTES = 147456;

#define ST_WT(p, v) __hip_atomic_store((p), (v), __ATOMIC_RELAXED, __HIP_MEMORY_SCOPE_AGENT)
#define LDS_WAIT() asm volatile("s_waitcnt lgkmcnt(0)" ::: "memory")
#define VM_WAIT() asm volatile("s_waitcnt vmcnt(0)" ::: "memory")

#define XB_TMO      128
#define XB_XCNT(j)  (256  + 64 * (j))
#define XB_XSUB(j)  (1280 + 64 * (j))
#define XB_XGEN(j)  (2304 + 64 * (j))
#define XB_TOP      3328
#define XB_TOPGEN   3392
#define XCD_BAR_WORDS 3456
#define XB_SPIN_CAP (1u << 18)
__device__ __forceinline__ unsigned xb_ld(unsigned* p)              { return __hip_atomic_load(p, __ATOMIC_RELAXED, __HIP_MEMORY_SCOPE_AGENT); }
__device__ __forceinline__ unsigned xb_add(unsigned* p, unsigned v) { return __hip_atomic_fetch_add(p, v, __ATOMIC_RELAXED, __HIP_MEMORY_SCOPE_AGENT); }
__device__ __forceinline__ unsigned xb_xcc_id() { return (unsigned)__builtin_amdgcn_s_getreg((3 << 11) | 20) & 0xFu; }
#define XB_SPIN(cond, bar) do { unsigned _sp = 0; while (cond) { __builtin_amdgcn_s_sleep(1); \
    if ((++_sp & 255u) == 0u) { if (xb_ld(&(bar)[XB_TMO])) break; if (_sp > XB_SPIN_CAP) { atomicAdd(&(bar)[XB_TMO], 1u); break; } } } } while (0)
struct XcdBarrier { unsigned* bar; unsigned x; volatile LAS unsigned* st; };
__device__ __forceinline__ XcdBarrier xcd_barrier_post(unsigned* bar, volatile LAS unsigned* st) {
    XcdBarrier b; b.bar = bar; b.x = xb_xcc_id(); b.st = st;
    if (threadIdx.x == 0) (void)xb_add(&bar[XB_XCNT(b.x)], 1u);
    return b;
}
__device__ __forceinline__ void xcd_barrier_complete(unsigned* bar, unsigned x, unsigned& nloc, unsigned& nx) {
    const unsigned G = gridDim.x * gridDim.y * gridDim.z;
    unsigned sum, cnt, mine, sp = 0u;
    for (;;) {
        sum = 0u; cnt = 0u; mine = 0u;
#pragma unroll
        for (unsigned j = 0; j < 16; ++j) { const unsigned c = xb_ld(&bar[XB_XCNT(j)]); sum += c; cnt += (c > 0u) ? 1u : 0u; mine = (j == x) ? c : mine; }
        if (sum == G) break;
        __builtin_amdgcn_s_sleep(1);
        if ((++sp & 255u) == 0u) { if (xb_ld(&bar[XB_TMO])) break; if (sp > XB_SPIN_CAP) { atomicAdd(&bar[XB_TMO], 1u); break; } }
    }
    nloc = mine > 0u ? mine : 1u; nx = cnt > 0u ? cnt : 1u;
}
__device__ __forceinline__ void xcd_barrier(const XcdBarrier& b) {
    asm volatile("s_waitcnt vmcnt(0)" ::: "memory");
    __syncthreads();
    if (threadIdx.x == 0) {
        unsigned* bar = b.bar;
        __builtin_amdgcn_s_waitcnt(0);
        unsigned nloc = b.st[0], nx = b.st[1];
        if (nloc == 0u) { xcd_barrier_complete(bar, b.x, nloc, nx); b.st[0] = nloc; b.st[1] = nx; }
        const unsigned old = xb_add(&bar[XB_XSUB(b.x)], 1u);
        const unsigned gen = old / nloc;
        if (old + 1u == (gen + 1u) * nloc) {
            __builtin_amdgcn_fence(__ATOMIC_RELEASE, "agent");
            asm volatile("s_waitcnt vmcnt(0)" ::: "memory");
            const unsigned og = xb_add(&bar[XB_TOP], 1u);
            const unsigned tg = og / nx;
            if (og + 1u == (tg + 1u) * nx) xb_add(&bar[XB_TOPGEN], 1u);
            else XB_SPIN(xb_ld(&bar[XB_TOPGEN]) == tg, bar);
            __builtin_amdgcn_fence(__ATOMIC_ACQUIRE, "agent");
            xb_add(&bar[XB_XGEN(b.x)], 1u);
            asm volatile("s_waitcnt vmcnt(0)" ::: "memory");
        } else {
            XB_SPIN(xb_ld(&bar[XB_XGEN(b.x)]) == gen, bar);
            __builtin_amdgcn_fence(__ATOMIC_ACQUIRE, "agent");
            asm volatile("s_waitcnt vmcnt(0)" ::: "memory");
        }
    }
    __syncthreads();
}

__device__ __forceinline__ void team_barrier(unsigned* ctr, unsigned target) {
    asm volatile("s_waitcnt vmcnt(0)" ::: "memory");
    __syncthreads();
    if (threadIdx.x == 0) {
        __builtin_amdgcn_fence(__ATOMIC_RELEASE, "agent");
        asm volatile("s_waitcnt vmcnt(0)" ::: "memory");
        (void)xb_add(ctr, 1u);
        for (unsigned sp = 0; xb_ld(ctr) < target && sp < (1u << 24); ++sp) __builtin_amdgcn_s_sleep(1);
        __builtin_amdgcn_fence(__ATOMIC_ACQUIRE, "agent");
        asm volatile("s_waitcnt vmcnt(0)" ::: "memory");
    }
    __syncthreads();
}

struct Frame {
    LAS unsigned char* lds;
    unsigned* ctl;
    int vcu, G;
    unsigned char* ws; float* out;
    const float *x, *w_in, *conv_w, *w_o, *ln1_g, *ln1_b, *rel_bias, *w_router, *router_bias, *eg, *eu, *ed, *sg, *su, *sd, *ln2_g, *ln2_b;
};
__device__ __forceinline__ float wave_sum(float v) {
#pragma unroll
    for (int o = 1; o < 64; o <<= 1) v += __shfl_xor(v, o);
    return v;
}

struct DenseOrder {
    int nM, nN, nwg, G, c, K; const char* Bt;
    __device__ __forceinline__ void init(int M, int N, int K_, int G_, int c_, const void* Bt_) { nM = M / 256; nN = N / 256; nwg = nM * nN; G = G_; c = c_; K = K_; Bt = (const char*)Bt_; }
    __device__ __forceinline__ bool next(int i, pg8::Unit& u) const {
        const long L = (long)i * G + c; if (L >= nwg) return false;
        int wgid = (int)L; { const int q = nwg / 8, r = nwg % 8, xcd = wgid % 8, off = wgid / 8; wgid = (xcd < r ? xcd * (q + 1) : r * (q + 1) + (xcd - r) * q) + off; }
        const int nig = 8 * nN, gid = wgid / nig, fm = gid * 8, gsz = (nM - fm) < 8 ? (nM - fm) : 8;
        u.pm = fm + ((wgid % nig) % gsz); u.pn = (wgid % nig) / gsz; u.aux = 0; return true;
    }
    __device__ __forceinline__ void a_off(const pg8::Unit& u, const int (&R)[2], const int (&C)[2], unsigned (&vo)[2][2]) const {
#pragma unroll
        for (int h = 0; h < 2; ++h)
#pragma unroll
            for (int i = 0; i < 2; ++i) vo[h][i] = (unsigned)((u.pm * 256 + 128 * h + R[i]) * K + C[i]) * 2u;
    }
    __device__ __forceinline__ const char* b_base(const pg8::Unit& u) const { return Bt + (size_t)u.pn * 256 * K * 2; }
};
struct MoeOrder {
    int nunits, G, c, shift, p0, K; const int* panel_e; const int* row_src; const char* W; size_t wbytes;
    __device__ __forceinline__ bool next(int i, pg8::Unit& u) const {
        const long L = (long)i * G + c; if (L >= nunits) return false;
        u.pm = p0 + (int)(L >> shift); u.pn = (int)(L & ((1 << shift) - 1)); u.aux = __builtin_amdgcn_readfirstlane(panel_e[u.pm]); return true;
    }
    __device__ __forceinline__ void a_off(const pg8::Unit& u, const int (&R)[2], const int (&C)[2], unsigned (&vo)[2][2]) const {
#pragma unroll
        for (int h = 0; h < 2; ++h)
#pragma unroll
            for (int i = 0; i < 2; ++i) {
                const int row = u.pm * 256 + 128 * h + R[i];
                vo[h][i] = row_src ? ((unsigned)row_src[row] * (unsigned)(K * 2) + (unsigned)C[i] * 2u) : ((unsigned)(row * K + C[i]) * 2u);
            }
    }
    __device__ __forceinline__ const char* b_base(const pg8::Unit& u) const { return W + (size_t)u.aux * wbytes + (size_t)u.pn * 256 * K * 2; }
};

struct EpiProj {
    static constexpr bool PERM = true;
    bf16_t* QKV; bf16_t* CV;
    __device__ __forceinline__ void operator()(const f32x4 (&acc)[2][2][4][2], const pg8::Unit& u, int wr, int wc, int fr, int fq) const {
        const int row0 = u.pm * 256 + wr * 64 + fr;
#pragma unroll
        for (int bj = 0; bj < 2; ++bj) { const int col = u.pn * 256 + bj * 128 + wc * 32 + 8 * fq;
            bf16_t* base; size_t rstride;
            if (col < 2304) { const int which = col / 768, hc = col % 768, h = hc >> 6, d = hc & 63; base = QKV + ((size_t)which * 32 * NH + h) * (SEQ * 64) + d; rstride = 0; }
            else { base = CV + (col - 2304); rstride = 1; }
#pragma unroll
            for (int ai = 0; ai < 2; ++ai)
#pragma unroll
                for (int m = 0; m < 4; ++m) { const int row = row0 + ai * 128 + m * 16; const int b = row >> 11, t = row & (SEQ - 1);
                    bf16_t* p = rstride ? base + (size_t)row * 768 : base + (size_t)b * NH * (SEQ * 64) + (size_t)t * 64;
                    const f32x4 v0 = acc[ai][bj][m][0], v1 = acc[ai][bj][m][1];
                    constexpr float r = 1.f / (X_SCALE * W13_SCALE);
                    u32x4 w; w.x = cvtpk(v0[0] * r, v0[1] * r); w.y = cvtpk(v0[2] * r, v0[3] * r); w.z = cvtpk(v1[0] * r, v1[1] * r); w.w = cvtpk(v1[2] * r, v1[3] * r);
                    *(u32x4*)p = w; }
        }
    }
};
struct EpiF32 {
    static constexpr bool PERM = false;
    float* C; int ldc;
    __device__ __forceinline__ void operator()(const f32x4 (&acc)[2][2][4][2], const pg8::Unit& u, int wr, int wc, int fr, int fq) const {
        const int row0 = u.pm * 256 + wr * 64 + fr, col0 = u.pn * 256 + wc * 32 + 4 * fq;
#pragma unroll
        for (int ai = 0; ai < 2; ++ai)
#pragma unroll
            for (int m = 0; m < 4; ++m) { float* rowp = C + (size_t)(row0 + ai * 128 + m * 16) * ldc + col0;
#pragma unroll
                for (int bj = 0; bj < 2; ++bj)
#pragma unroll
                    for (int n = 0; n < 2; ++n) *(f32x4*)(rowp + bj * 128 + n * 16) = acc[ai][bj][m][n]; }
    }
};
struct EpiWo {
    static constexpr bool PERM = true;
    bf16_t* Z; const float* X;
    __device__ __forceinline__ void operator()(const f32x4 (&acc)[2][2][4][2], const pg8::Unit& u, int wr, int wc, int fr, int fq) const {
        const int row0 = u.pm * 256 + wr * 64 + fr, col0 = u.pn * 256 + wc * 32 + 8 * fq;
#pragma unroll
        for (int ai = 0; ai < 2; ++ai)
#pragma unroll
            for (int m = 0; m < 4; ++m) { const size_t ro = (size_t)(row0 + ai * 128 + m * 16) * DM + col0;
#pragma unroll
                for (int bj = 0; bj < 2; ++bj) { const f32x4 x0 = *(const f32x4*)(X + ro + bj * 128), x1 = *(const f32x4*)(X + ro + bj * 128 + 4);
                    const f32x4 v0 = x0 * ALPHA + acc[ai][bj][m][0], v1 = x1 * ALPHA + acc[ai][bj][m][1];
                    u32x4 w; w.x = cvtpk(v0[0], v0[1]); w.y = cvtpk(v0[2], v0[3]); w.z = cvtpk(v1[0], v1[1]); w.w = cvtpk(v1[2], v1[3]);
                    *(u32x4*)(Z + ro + bj * 128) = w; } }
    }
};
__device__ __forceinline__ float silu_mul(float g, float u) { const float e = __builtin_amdgcn_exp2f(-g * LOG2E); return g * __builtin_amdgcn_rcpf(1.f + e) * u; }
constexpr float H_SCALE = 8.f, WD_SCALE = 8.f;
__device__ __forceinline__ float h8(float g, float u) { constexpr float r = 1.f / (X_SCALE * W13_SCALE); return __builtin_amdgcn_fmed3f(silu_mul(g * r, u * r) * H_SCALE, -448.f, 448.f); }
struct EpiGU {
    static constexpr bool PERM = true;
    unsigned char* H;
    __device__ __forceinline__ void operator()(const f32x4 (&acc)[2][2][4][2], const pg8::Unit& u, int wr, int wc, int fr, int fq) const {
        const int row0 = u.pm * 256 + wr * 64 + fr, col0 = u.pn * 128 + wc * 32 + 8 * fq;
#pragma unroll
        for (int ai = 0; ai < 2; ++ai)
#pragma unroll
            for (int m = 0; m < 4; ++m) { unsigned char* rowp = H + (size_t)(row0 + ai * 128 + m * 16) * EDIM + col0;
                const f32x4 g0 = acc[ai][0][m][0], g1 = acc[ai][0][m][1], u0 = acc[ai][1][m][0], u1 = acc[ai][1][m][1];
                int w0 = 0, w1 = 0;
                w0 = __builtin_amdgcn_cvt_pk_fp8_f32(h8(g0[0], u0[0]), h8(g0[1], u0[1]), w0, false); w0 = __builtin_amdgcn_cvt_pk_fp8_f32(h8(g0[2], u0[2]), h8(g0[3], u0[3]), w0, true);
                w1 = __builtin_amdgcn_cvt_pk_fp8_f32(h8(g1[0], u1[0]), h8(g1[1], u1[1]), w1, false); w1 = __builtin_amdgcn_cvt_pk_fp8_f32(h8(g1[2], u1[2]), h8(g1[3], u1[3]), w1, true);
                u32x2 w; w.x = (unsigned)w0; w.y = (unsigned)w1;
                *(u32x2*)rowp = w; }
    }
};
__device__ __forceinline__ int t5_bucket(int dist) {
    if (dist < 16) return dist;
    int b = 16;
    b += dist >= 22; b += dist >= 30; b += dist >= 40; b += dist >= 54; b += dist >= 73; b += dist >= 99; b += dist >= 134; b += dist >= 182;
    b += dist >= 246; b += dist >= 332; b += dist >= 450; b += dist >= 609; b += dist >= 825; b += dist >= 1117; b += dist >= 1513;
    return b;
}
__device__ __forceinline__ void transpose_item(const float* W, int N, int k0, int n0, bf16_t* WT, int ldk, int out_row0, LAS float* scr, int lane) {
#pragma unroll 8
    for (int i = 0; i < 32; ++i) { const int kk = 2 * i + (lane >> 5); scr[kk * 33 + (lane & 31)] = W[(size_t)(k0 + kk) * N + n0 + (lane & 31)]; }
    LDS_WAIT(); asm volatile("" ::: "memory");
    const int c = lane & 7;
#pragma unroll
    for (int j = 0; j < 4; ++j) { const int n = (lane >> 3) + 8 * j; const LAS float* s = scr + (8 * c) * 33 + n;
        u32x4 o; o.x = cvtpk(s[0 * 33], s[1 * 33]); o.y = cvtpk(s[2 * 33], s[3 * 33]); o.z = cvtpk(s[4 * 33], s[5 * 33]); o.w = cvtpk(s[6 * 33], s[7 * 33]);
        *(u32x4*)(WT + (size_t)(out_row0 + n) * ldk + k0 + 8 * c) = o; }
    LDS_WAIT(); asm volatile("" ::: "memory");
}
__device__ __forceinline__ void transpose_item8(const float* W, int N, int k0, int n0, unsigned char* WT, int ldk, int out_row0, float sc, LAS float* scr, int lane) {
#pragma unroll 8
    for (int i = 0; i < 32; ++i) { const int kk = 2 * i + (lane >> 5); scr[kk * 33 + (lane & 31)] = W[(size_t)(k0 + kk) * N + n0 + (lane & 31)]; }
    LDS_WAIT(); asm volatile("" ::: "memory");
    const int c = lane & 3;
#pragma unroll
    for (int j = 0; j < 2; ++j) { const int n = (lane >> 2) + 16 * j; const LAS float* s = scr + (16 * c) * 33 + n;
        int w0 = 0, w1 = 0, w2 = 0, w3 = 0;
        w0 = __builtin_amdgcn_cvt_pk_fp8_f32(s[0 * 33] * sc, s[1 * 33] * sc, w0, false); w0 = __builtin_amdgcn_cvt_pk_fp8_f32(s[2 * 33] * sc, s[3 * 33] * sc, w0, true);
        w1 = __builtin_amdgcn_cvt_pk_fp8_f32(s[4 * 33] * sc, s[5 * 33] * sc, w1, false); w1 = __builtin_amdgcn_cvt_pk_fp8_f32(s[6 * 33] * sc, s[7 * 33] * sc, w1, true);
        w2 = __builtin_amdgcn_cvt_pk_fp8_f32(s[8 * 33] * sc, s[9 * 33] * sc, w2, false); w2 = __builtin_amdgcn_cvt_pk_fp8_f32(s[10 * 33] * sc, s[11 * 33] * sc, w2, true);
        w3 = __builtin_amdgcn_cvt_pk_fp8_f32(s[12 * 33] * sc, s[13 * 33] * sc, w3, false); w3 = __builtin_amdgcn_cvt_pk_fp8_f32(s[14 * 33] * sc, s[15 * 33] * sc, w3, true);
        u32x4 o; o.x = (unsigned)w0; o.y = (unsigned)w1; o.z = (unsigned)w2; o.w = (unsigned)w3;
        *(u32x4*)(WT + (size_t)(out_row0 + n) * ldk + k0 + 16 * c) = o; }
    LDS_WAIT(); asm volatile("" ::: "memory");
}
__device__ __forceinline__ void p0_prologue(Frame& F) {
    const int tid_ = opaque_tid(), lane_ = tid_ & 63, wave_ = __builtin_amdgcn_readfirstlane(tid_ >> 6);
    LAS float* scr = (LAS float*)(F.lds + wave_ * 8448);
    const int gw = F.vcu * NWAVES + wave_, NGW = F.G * NWAVES, lane = lane_;
    bf16_t* win_t = (bf16_t*)(F.ws + WS_WIN); bf16_t* wo_t = (bf16_t*)(F.ws + WS_WO); bf16_t* wr_t = (bf16_t*)(F.ws + WS_WR);
    unsigned char* w13 = F.ws + WS_W13  ; unsigned char* wd = F.ws + WS_WD;
    constexpr int I_IN = 16 * 96, I_O = 16 * 32, I_R = 16 * 8, I_SMALL = I_IN + I_O + I_R;
    for (int it = gw; it < I_SMALL; it += NGW) {
        int r = it;
        if (r < I_IN) { const int kb = r / 96, nb = r % 96; transpose_item8(F.w_in, PROJW, 64 * kb, 32 * nb, (unsigned char*)win_t, DM, 32 * nb, W13_SCALE, scr, lane); continue; } r -= I_IN;
        if (r < I_O) { const int kb = r / 32, nb = r % 32; transpose_item(F.w_o, DM, 64 * kb, 32 * nb, wo_t, DM, 32 * nb, scr, lane); continue; } r -= I_O;
        { const int kb = r / 8, nb = r % 8; transpose_item(F.w_router, NEXP, 64 * kb, 32 * nb, wr_t, DM, 32 * nb, scr, lane); }
    }
    { float* bt = (float*)(F.ws + WS_BIAS);
      for (int i = F.vcu * 512 + tid_; i < 3 * NH * 192; i += F.G * 512) { const int g = i / (NH * 192), r = i % (NH * 192), h = r / 192, e = r % 192, st = e - 32;
        float v = -INFINITY; if (st >= 0 && st <= 128) v = F.rel_bias[t5_bucket(st << (2 * g)) * NH + h] * LOG2E; bt[i] = v; } }
    { const f32x4* xs = (const f32x4*)F.x; u32x4* xd = (u32x4*)(F.ws + WS_XB); const size_t n16 = (size_t)NTOK * DM / 16, stride = (size_t)F.G * 512;
        for (size_t i = (size_t)F.vcu * 512 + tid_; i < n16; i += stride) { u32x4 o; int wv[4];
#pragma unroll
            for (int j = 0; j < 4; ++j) { const f32x4 a = xs[4 * i + j]; int wj = 0;
                wj = __builtin_amdgcn_cvt_pk_fp8_f32(__builtin_amdgcn_fmed3f(a[0] * X_SCALE, -448.f, 448.f), __builtin_amdgcn_fmed3f(a[1] * X_SCALE, -448.f, 448.f), wj, false);
                wj = __builtin_amdgcn_cvt_pk_fp8_f32(__builtin_amdgcn_fmed3f(a[2] * X_SCALE, -448.f, 448.f), __builtin_amdgcn_fmed3f(a[3] * X_SCALE, -448.f, 448.f), wj, true); wv[j] = wj; }
            o.x = (unsigned)wv[0]; o.y = (unsigned)wv[1]; o.z = (unsigned)wv[2]; o.w = (unsigned)wv[3]; xd[i] = o; } }
}

__device__ __forceinline__ float lane_swap_max(float m) { asm volatile("s_nop 7" : "+v"(m)); auto rr = __builtin_amdgcn_permlane32_swap(__float_as_uint(m), __float_as_uint(m), false, false); unsigned r0 = rr[0], r1 = rr[1]; asm volatile("s_nop 7" : "+v"(r0), "+v"(r1)); return fmaxf(__uint_as_float(r0), __uint_as_float(r1)); }
__device__ __forceinline__ float lane_swap_sum(float m) { asm volatile("s_nop 7" : "+v"(m)); auto rr = __builtin_amdgcn_permlane32_swap(__float_as_uint(m), __float_as_uint(m), false, false); unsigned r0 = rr[0], r1 = rr[1]; asm volatile("s_nop 7" : "+v"(r0), "+v"(r1)); return __uint_as_float(r0) + __uint_as_float(r1); }
__device__ __forceinline__ int crow(int r, int hi) { return (r & 3) + 8 * (r >> 2) + 4 * hi; }

template <int GB>
__device__ __forceinline__ void attn_pair(Frame& F, int pair) {
    const int tid_ = opaque_tid(), lane_ = tid_ & 63, wave_ = __builtin_amdgcn_readfirstlane(tid_ >> 6);
    constexpr int DIL = 1 << (2 * GB), NB = 16 / DIL;
    const int tid = tid_, hw = wave_ >> 2, w = wave_ & 3, ht = tid & 255, lane = lane_, r32 = lane & 31, hi = lane >> 5;
    const int u = pair * 2 + hw;
    const int b = u / 192, rem = u % 192, hh = rem >> 4, blk = rem & 15;
    const int r = blk / NB, n = blk % NB;
    LAS unsigned char* base = F.lds + hw * ATT_HALF;
    LAS unsigned char* Kl = base + ATT_K; LAS unsigned char* Vl = base + ATT_V; LAS float* tbl = (LAS float*)(base + ATT_TBL); LAS float* sc = (LAS float*)(base + ATT_SC + w * 256);
    const bf16_t* proj = (const bf16_t*)(F.ws + WS_PROJ);
    bf16_t* A2 = (bf16_t*)(F.ws + WS_XB); float* lse_buf = (float*)(F.ws + WS_LSE);
    const size_t tok0 = (size_t)b * SEQ + r;
    const bf16_t* qh = proj + ((size_t)(0 * 32 + b) * NH + hh) * (SEQ * 64); const bf16_t* kh = proj + ((size_t)(1 * 32 + b) * NH + hh) * (SEQ * 64); const bf16_t* vh = proj + ((size_t)(2 * 32 + b) * NH + hh) * (SEQ * 64);
    if (ht < 192) tbl[ht] = ((const float*)(F.ws + WS_BIAS))[(GB * NH + hh) * 192 + ht];
    {
        const int c = ht & 7, rb = ht >> 3;
        u32x4 kv[8], vv[8];
#pragma unroll
        for (int it = 0; it < 8; ++it) { const int ki = it * 32 + rb, l = 128 * (n - 1) + ki;
            if (l >= 0) { const size_t ro = (size_t)(l * DIL + r) * 64 + c * 8; kv[it] = *(const u32x4*)(kh + ro); vv[it] = *(const u32x4*)(vh + ro); }
            else { kv[it] = (u32x4){0u, 0u, 0u, 0u}; vv[it] = (u32x4){0u, 0u, 0u, 0u}; } }
#pragma unroll
        for (int it = 0; it < 8; ++it) { const int ki = it * 32 + rb;
            *(LAS u32x4*)(Kl + ki * 144 + c * 16) = kv[it];
            const u32x4 v = vv[it]; const int sw = ((ki >> 1) & 1) * 64;
            u32x2 ev, od; ev.x = (v.x & 0xffffu) | (v.y << 16); ev.y = (v.z & 0xffffu) | (v.w << 16); od.x = (v.x >> 16) | (v.y & 0xffff0000u); od.y = (v.z >> 16) | (v.w & 0xffff0000u);
            *(LAS u32x2*)(Vl + ki * 128 + (0 ^ sw) + c * 8) = ev; *(LAS u32x2*)(Vl + ki * 128 + (64 ^ sw) + c * 8) = od; }
    }
    bf16x8 qf[4];
    const int lq = 128 * n + 32 * w + r32;
    { const bf16_t* qs = qh + (size_t)(lq * DIL + r) * 64 + hi * 8;
#pragma unroll
        for (int ds = 0; ds < 4; ++ds) qf[ds] = *(const bf16x8*)(qs + ds * 16); }
    __syncthreads();
    f32x16 S[5];
    constexpr float SC = 0.125f * LOG2E;
#pragma unroll
    for (int jj = 0; jj < 5; ++jj) {
        const int j = w + jj; const bool act = (n > 0) || (j >= 4);
        if (act) {
            f32x16 a;
#pragma unroll
            for (int i = 0; i < 16; ++i) a[i] = 0.f;
            asm volatile("" : "+v"(a));
            const LAS unsigned char* kp = Kl + (32 * j + r32) * 144 + hi * 16;
#pragma unroll
            for (int ds = 0; ds < 4; ++ds) { const bf16x8 kf = *(const LAS bf16x8*)(kp + ds * 32); a = __builtin_amdgcn_mfma_f32_32x32x16_bf16(kf, qf[ds], a, 0, 0, 0); }
            const int ib = 160 - 32 * jj + r32 - 4 * hi;
#pragma unroll
            for (int i = 0; i < 16; ++i) a[i] = a[i] * SC + *(volatile LAS float*)(tbl + (ib - (i & 3) - 8 * (i >> 2)));
            S[jj] = a;
        } else {
#pragma unroll
            for (int i = 0; i < 16; ++i) S[jj][i] = -INFINITY;
        }
    }
    float m = -INFINITY;
#pragma unroll
    for (int jj = 0; jj < 5; ++jj)
#pragma unroll
        for (int i = 0; i < 16; ++i) m = fmaxf(m, S[jj][i]);
    m = lane_swap_max(m);
    float lsum = 0.f;
#pragma unroll
    for (int jj = 0; jj < 5; ++jj)
#pragma unroll
        for (int i = 0; i < 16; ++i) { const float p = __builtin_amdgcn_exp2f(S[jj][i] - m); S[jj][i] = p; lsum += p; }
    lsum = lane_swap_sum(lsum);
    f32x16 o[2];
#pragma unroll
    for (int i = 0; i < 16; ++i) { o[0][i] = 0.f; o[1][i] = 0.f; }
    asm volatile("" : "+v"(o[0]), "+v"(o[1]));
    { const int q4 = (lane & 15) >> 2, p4 = lane & 3, cb = (lane >> 4) & 1, swz = ((q4 >> 1) & 1) * 64;
        const LAS unsigned char* vb = Vl + (4 * hi + q4) * 128 + cb * 32 + p4 * 8;
#pragma unroll
        for (int jj = 0; jj < 5; ++jj) {
            const int j = w + jj; const bool act = (n > 0) || (j >= 4);
            if (act) {
#pragma unroll
                for (int s = 0; s < 2; ++s) {
                    u32x4 pw; pw.x = cvtpk(S[jj][8 * s + 0], S[jj][8 * s + 1]); pw.y = cvtpk(S[jj][8 * s + 2], S[jj][8 * s + 3]); pw.z = cvtpk(S[jj][8 * s + 4], S[jj][8 * s + 5]); pw.w = cvtpk(S[jj][8 * s + 6], S[jj][8 * s + 7]);
                    const bf16x8 pa = __builtin_bit_cast(bf16x8, pw);
#pragma unroll
                    for (int dh = 0; dh < 2; ++dh) {
                        const LAS unsigned char* vp = vb + (32 * j + 16 * s) * 128 + ((dh * 64) ^ swz);
                        const s16x4 lo = __builtin_bit_cast(s16x4, __builtin_amdgcn_ds_read_tr16_b64_v4i16((LAS v4i16_t*)vp));
                        const s16x4 hi4 = __builtin_bit_cast(s16x4, __builtin_amdgcn_ds_read_tr16_b64_v4i16((LAS v4i16_t*)(vp + 8 * 128)));
                        const bf16x8 vf = (bf16x8){lo[0], lo[1], lo[2], lo[3], hi4[0], hi4[1], hi4[2], hi4[3]};
                        o[dh] = __builtin_amdgcn_mfma_f32_32x32x16_bf16(pa, vf, o[dh], 0, 0, 0);
                    }
                }
            }
        }
    }
    {
        const size_t tq = tok0 + (size_t)lq * DIL;
        const float lse_new = m + __builtin_amdgcn_logf(lsum);
        float a = 0.f, bco = __builtin_amdgcn_rcpf(lsum), lse_out = lse_new;
        if (GB > 0) {
            const float lp = lse_buf[tq * NH + hh];
            const float M = fmaxf(lp, lse_new), wp = __builtin_amdgcn_exp2f(lp - M), wn = __builtin_amdgcn_exp2f(lse_new - M), den = wp + wn, rd = __builtin_amdgcn_rcpf(den);
            a = wp * rd; bco = wn * rd * __builtin_amdgcn_rcpf(lsum); lse_out = M + __builtin_amdgcn_logf(den);
        }
        if (hi == 0) { sc[r32] = a; sc[32 + r32] = bco; if (GB < 2) ST_WT(lse_buf + tq * NH + hh, lse_out); }
        LDS_WAIT();
    }
    unsigned pvv[16];
    if (GB > 0) {
#pragma unroll
        for (int i = 0; i < 16; ++i) { const size_t tq = tok0 + (size_t)(128 * n + 32 * w + crow(i, hi)) * DIL; pvv[i] = *((const unsigned*)(A2 + tq * DM + hh * 64) + r32); }
        asm volatile("s_waitcnt vmcnt(0)" ::: "memory");
    }
#pragma unroll
    for (int i = 0; i < 16; ++i) {
        const int q = crow(i, hi); const float a = sc[q], bco = sc[32 + q];
        const size_t tq = tok0 + (size_t)(128 * n + 32 * w + q) * DIL;
        unsigned* dst = (unsigned*)(A2 + tq * DM + hh * 64) + r32;
        float v0 = o[0][i] * bco, v1 = o[1][i] * bco;
        if (GB > 0) { v0 += a * bflo(pvv[i]); v1 += a * bfhi(pvv[i]); }
        *dst = cvtpk(v0, v1);
    }
    __syncthreads();
}
template <int GB>
__device__ __forceinline__ void attn_branch(Frame& F) { for (int pair = F.vcu; pair < 3072; pair += F.G) attn_pair<GB>(F, pair); }

__device__ __forceinline__ void conv_phase(Frame& F) {
    const int tid_ = opaque_tid(), lane_ = tid_ & 63, wave_ = __builtin_amdgcn_readfirstlane(tid_ >> 6);
    const bf16_t* cvin = (const bf16_t*)(F.ws + WS_CONVIN); bf16_t* A2 = (bf16_t*)(F.ws + WS_XB);
    const int gw = F.vcu * NWAVES + wave_, NGW = F.G * NWAVES, c0 = lane_ * 4;
    float w0[4], w1[4], w2[4];
#pragma unroll
    for (int j = 0; j < 4; ++j) { w0[j] = F.conv_w[c0 + j]; w1[j] = F.conv_w[256 + c0 + j]; w2[j] = F.conv_w[512 + c0 + j]; }
    for (int t = gw; t < NTOK; t += NGW) {
        const int ts = t & (SEQ - 1);
        float y[4] = {0.f, 0.f, 0.f, 0.f};
#pragma unroll
        for (int k = 0; k < 3; ++k) {
            if (ts - 2 + k >= 0) { const bf16_t* row = cvin + (size_t)(t - 2 + k) * 768;
                const u32x2 cx = *(const u32x2*)(row + c0), cc = *(const u32x2*)(row + 512 + c0);
                const float uu[4] = {bflo(cx.x) * bflo(cc.x), bfhi(cx.x) * bfhi(cc.x), bflo(cx.y) * bflo(cc.y), bfhi(cx.y) * bfhi(cc.y)};
#pragma unroll
                for (int j = 0; j < 4; ++j) y[j] += uu[j] * (k == 0 ? w0[j] : k == 1 ? w1[j] : w2[j]); }
        }
        const u32x2 cb = *(const u32x2*)(cvin + (size_t)t * 768 + 256 + c0);
        u32x2 ov; ov.x = cvtpk(bflo(cb.x) * y[0], bfhi(cb.x) * y[1]); ov.y = cvtpk(bflo(cb.y) * y[2], bfhi(cb.y) * y[3]);
        *(u32x2*)(A2 + (size_t)t * DM + 768 + c0) = ov;
    }
}

__device__ __forceinline__ void ln1_phase(Frame& F) {
    const int tid_ = opaque_tid(), lane_ = tid_ & 63, wave_ = __builtin_amdgcn_readfirstlane(tid_ >> 6);
    const bf16_t* z = (const bf16_t*)F.out; bf16_t* x1 = (bf16_t*)(F.ws + WS_XB);
    const int gw = F.vcu * NWAVES + wave_, NGW = F.G * NWAVES;
    f32x4 g[4], bb[4];
#pragma unroll
    for (int j = 0; j < 4; ++j) { g[j] = *(const f32x4*)(F.ln1_g + lane_ * 16 + 4 * j); bb[j] = *(const f32x4*)(F.ln1_b + lane_ * 16 + 4 * j); }
    for (int mrow = gw; mrow < NTOK; mrow += NGW) {
        const u32x4* zr = (const u32x4*)(z + (size_t)mrow * DM) + 2 * lane_; const u32x4 a = zr[0], b = zr[1];
        float v[16] = {bflo(a.x), bfhi(a.x), bflo(a.y), bfhi(a.y), bflo(a.z), bfhi(a.z), bflo(a.w), bfhi(a.w), bflo(b.x), bfhi(b.x), bflo(b.y), bfhi(b.y), bflo(b.z), bfhi(b.z), bflo(b.w), bfhi(b.w)};
        float s = 0.f;
#pragma unroll
        for (int i = 0; i < 16; ++i) s += v[i];
        const float mean = wave_sum(s) * (1.f / DM); float s2 = 0.f;
#pragma unroll
        for (int i = 0; i < 16; ++i) { v[i] -= mean; s2 += v[i] * v[i]; }
        const float rstd = 1.f / sqrtf(wave_sum(s2) * (1.f / DM) + LN_EPS);
        u32x4 o0, o1;
        { const f32x4 y0 = (f32x4){v[0], v[1], v[2], v[3]} * rstd * g[0] + bb[0], y1 = (f32x4){v[4], v[5], v[6], v[7]} * rstd * g[1] + bb[1];
          const f32x4 y2 = (f32x4){v[8], v[9], v[10], v[11]} * rstd * g[2] + bb[2], y3 = (f32x4){v[12], v[13], v[14], v[15]} * rstd * g[3] + bb[3];
          o0.x = cvtpk(y0.x, y0.y); o0.y = cvtpk(y0.z, y0.w); o0.z = cvtpk(y1.x, y1.y); o0.w = cvtpk(y1.z, y1.w);
          o1.x = cvtpk(y2.x, y2.y); o1.y = cvtpk(y2.z, y2.w); o1.z = cvtpk(y3.x, y3.y); o1.w = cvtpk(y3.z, y3.w); }
        u32x4* xo = (u32x4*)(x1 + (size_t)mrow * DM) + 2 * lane_; xo[0] = o0; xo[1] = o1;
        { u32x4 q;
          const float r = rstd * X_SCALE; const f32x4 gb0 = bb[0] * X_SCALE, gb1 = bb[1] * X_SCALE, gb2 = bb[2] * X_SCALE, gb3 = bb[3] * X_SCALE;
          const f32x4 y0 = (f32x4){v[0], v[1], v[2], v[3]} * r * g[0] + gb0, y1 = (f32x4){v[4], v[5], v[6], v[7]} * r * g[1] + gb1;
          const f32x4 y2 = (f32x4){v[8], v[9], v[10], v[11]} * r * g[2] + gb2, y3 = (f32x4){v[12], v[13], v[14], v[15]} * r * g[3] + gb3;
          int w0 = 0, w1 = 0, w2 = 0, w3 = 0;
          w0 = __builtin_amdgcn_cvt_pk_fp8_f32(y0.x, y0.y, w0, false); w0 = __builtin_amdgcn_cvt_pk_fp8_f32(y0.z, y0.w, w0, true);
          w1 = __builtin_amdgcn_cvt_pk_fp8_f32(y1.x, y1.y, w1, false); w1 = __builtin_amdgcn_cvt_pk_fp8_f32(y1.z, y1.w, w1, true);
          w2 = __builtin_amdgcn_cvt_pk_fp8_f32(y2.x, y2.y, w2, false); w2 = __builtin_amdgcn_cvt_pk_fp8_f32(y2.z, y2.w, w2, true);
          w3 = __builtin_amdgcn_cvt_pk_fp8_f32(y3.x, y3.y, w3, false); w3 = __builtin_amdgcn_cvt_pk_fp8_f32(y3.z, y3.w, w3, true);
          q.x = (unsigned)w0; q.y = (unsigned)w1; q.z = (unsigned)w2; q.w = (unsigned)w3;
          *((u32x4*)(F.ws + WS_X8 + (size_t)mrow * DM) + lane_) = q; }
    }
}

template <int CTRL> __device__ __forceinline__ float dpp_f(float x) { return __builtin_bit_cast(float, __builtin_amdgcn_update_dpp(0, __builtin_bit_cast(int, x), CTRL, 0xf, 0xf, true)); }
__device__ __forceinline__ float wave_max_uniform(float x) {
    x = fmaxf(x, dpp_f<0xB1>(x)); x = fmaxf(x, dpp_f<0x4E>(x)); x = fmaxf(x, dpp_f<0x141>(x)); x = fmaxf(x, dpp_f<0x140>(x));
    const float r0 = __builtin_bit_cast(float, __builtin_amdgcn_readlane(__builtin_bit_cast(int, x), 0)), r1 = __builtin_bit_cast(float, __builtin_amdgcn_readlane(__builtin_bit_cast(int, x), 16));
    const float r2 = __builtin_bit_cast(float, __builtin_amdgcn_readlane(__builtin_bit_cast(int, x), 32)), r3 = __builtin_bit_cast(float, __builtin_amdgcn_readlane(__builtin_bit_cast(int, x), 48));
    return fmaxf(fmaxf(r0, r1), fmaxf(r2, r3));
}
constexpr int CV_ITEMS_E = 384, CV_ITEMS = 257 * CV_ITEMS_E;
struct CvItem { const float* src; unsigned char* dst; int N, ldk; float sc; bool valid; };
__device__ __forceinline__ CvItem cv_decode(const Frame& F, int it, int lane) {
    CvItem c; c.valid = it < CV_ITEMS; if (!c.valid) it = 0;
    const int e = it / CV_ITEMS_E; int r = it % CV_ITEMS_E;
    const float* W; int N, k0, n0, orow; unsigned char* WT;
    if (r < 256) { const bool up = r >= 128; r &= 127; const int kb = r >> 3, nb = r & 7; n0 = 32 * nb; k0 = 64 * kb; N = EDIM;
        W = e < 256 ? (up ? F.eu : F.eg) + (size_t)e * DM * EDIM : (up ? F.su : F.sg); orow = (n0 >> 7) * 256 + (up ? 128 : 0) + (n0 & 127);
        WT = F.ws + WS_W13 + (size_t)e * 512 * DM; c.ldk = DM; c.sc = W13_SCALE; }
    else { r -= 256; const int kb = r >> 5, nb = r & 31; n0 = 32 * nb; k0 = 64 * kb; N = DM;
        W = e < 256 ? F.ed + (size_t)e * EDIM * DM : F.sd; orow = n0;
        WT = F.ws + WS_WD + (size_t)e * DM * EDIM; c.ldk = EDIM; c.sc = WD_SCALE; }
    c.N = N; c.src = W + (size_t)(k0 + (lane >> 5)) * N + n0 + (lane & 31); c.dst = WT + (size_t)orow * c.ldk + k0;
    return c;
}
__device__ __forceinline__ void cv_load(const CvItem& c, float (&r)[32]) {
    if (c.valid) {
#pragma unroll
        for (int i = 0; i < 32; ++i) { const float* p = c.src + (size_t)(2 * i) * c.N; asm volatile("global_load_dword %0, %1, off" : "=v"(r[i]) : "v"(p) : "memory"); }
    }
}
__device__ __forceinline__ void cv_finish(const CvItem& c, const float (&r)[32], LAS float* scr, int lane) {
    if (c.valid) {
#pragma unroll
        for (int i = 0; i < 32; ++i) scr[(2 * i + (lane >> 5)) * 33 + (lane & 31)] = r[i];
        LDS_WAIT(); asm volatile("" ::: "memory");
        const int cc = lane & 3; const float sc = c.sc;
#pragma unroll
        for (int j = 0; j < 2; ++j) { const int n = (lane >> 2) + 16 * j; const volatile LAS float* s = scr + (16 * cc) * 33 + n;
            int w0 = 0, w1 = 0, w2 = 0, w3 = 0;
            w0 = __builtin_amdgcn_cvt_pk_fp8_f32(s[0 * 33] * sc, s[1 * 33] * sc, w0, false); w0 = __builtin_amdgcn_cvt_pk_fp8_f32(s[2 * 33] * sc, s[3 * 33] * sc, w0, true);
            w1 = __builtin_amdgcn_cvt_pk_fp8_f32(s[4 * 33] * sc, s[5 * 33] * sc, w1, false); w1 = __builtin_amdgcn_cvt_pk_fp8_f32(s[6 * 33] * sc, s[7 * 33] * sc, w1, true);
            w2 = __builtin_amdgcn_cvt_pk_fp8_f32(s[8 * 33] * sc, s[9 * 33] * sc, w2, false); w2 = __builtin_amdgcn_cvt_pk_fp8_f32(s[10 * 33] * sc, s[11 * 33] * sc, w2, true);
            w3 = __builtin_amdgcn_cvt_pk_fp8_f32(s[12 * 33] * sc, s[13 * 33] * sc, w3, false); w3 = __builtin_amdgcn_cvt_pk_fp8_f32(s[14 * 33] * sc, s[15 * 33] * sc, w3, true);
            u32x4 o; o.x = (unsigned)w0; o.y = (unsigned)w1; o.z = (unsigned)w2; o.w = (unsigned)w3;
            *(u32x4*)(c.dst + (size_t)n * c.ldk + 16 * cc) = o; }
        LDS_WAIT(); asm volatile("" ::: "memory");
    }
}
__device__ __forceinline__ void route_phase(Frame& F) {
    const int tid_ = opaque_tid(), lane_ = tid_ & 63, wave_ = __builtin_amdgcn_readfirstlane(tid_ >> 6);
    const float* logits = (const float*)(F.ws + WS_LOGIT); int* top_e = (int*)(F.ws + WS_TOPE); float* top_w = (float*)(F.ws + WS_TOPW);
    LAS int* lhist = (LAS int*)(F.lds + 8 * 8448);
    LAS float* scr = (LAS float*)(F.lds + wave_ * 8448);
    const int lane = lane_;
    const int cv_stride = F.G * NWAVES; int cv_next = F.vcu * NWAVES + wave_;
    float rb[4];
#pragma unroll
    for (int j = 0; j < 4; ++j) rb[j] = F.router_bias[lane * 4 + j];
    for (int chunk = F.vcu; chunk < NTOK / 256; chunk += F.G) {
        if (tid_ < 256) lhist[tid_] = 0;
        __syncthreads();
        const f32x4* lgp = (const f32x4*)(logits + (size_t)(chunk * 256 + wave_ * 32) * NEXP) + lane;
        f32x4 lg1 = lgp[0], lg2 = lgp[64];
#pragma unroll 1
        for (int tt = 0; tt < 32; ++tt) {
            const int t = chunk * 256 + wave_ * 32 + tt;
            asm volatile("s_waitcnt vmcnt(0)" ::: "memory");
            f32x4 lg = lg1; lg1 = lg2; if (tt + 2 < 32) lg2 = lgp[(tt + 2) * 64];
            asm volatile("" : "+v"(lg), "+v"(lg1));
            __builtin_amdgcn_sched_barrier(0);
            const CvItem ca = cv_decode(F, cv_next, lane), cb = cv_decode(F, cv_next + cv_stride, lane); cv_next += 2 * cv_stride;
            float ra[32], rbuf[32];
            cv_load(ca, ra); cv_load(cb, rbuf);
            __builtin_amdgcn_sched_barrier(0);
            float s[4], v[4];
#pragma unroll
            for (int j = 0; j < 4; ++j) { s[j] = __builtin_amdgcn_rcpf(1.f + __builtin_amdgcn_exp2f(-lg[j] * LOG2E)); v[j] = s[j] + rb[j]; }
            float t1, t2;
            { const float a1 = fmaxf(v[0], v[1]), a2 = fminf(v[0], v[1]), b1 = fmaxf(v[2], v[3]), b2 = fminf(v[2], v[3]); t1 = fmaxf(a1, b1); t2 = fmaxf(fminf(a1, b1), fmaxf(a2, b2)); }
            { const float o1 = dpp_f<0xB1>(t1), o2 = dpp_f<0xB1>(t2); const float n1 = fmaxf(t1, o1), n2 = fmaxf(fminf(t1, o1), fmaxf(t2, o2)); t1 = n1; t2 = n2; }
            { const float o1 = dpp_f<0x4E>(t1), o2 = dpp_f<0x4E>(t2); const float n1 = fmaxf(t1, o1), n2 = fmaxf(fminf(t1, o1), fmaxf(t2, o2)); t1 = n1; t2 = n2; }
            { const float o1 = dpp_f<0x141>(t1), o2 = dpp_f<0x141>(t2); const float n1 = fmaxf(t1, o1), n2 = fmaxf(fminf(t1, o1), fmaxf(t2, o2)); t1 = n1; t2 = n2; }
            const float gs = t1 + t2; const int g = lane >> 3; int rank = 0;
#pragma unroll
            for (int gg = 0; gg < 8; ++gg) { const float og = __builtin_bit_cast(float, __builtin_amdgcn_readlane(__builtin_bit_cast(int, gs), 8 * gg)); rank += (og > gs || (og == gs && gg < g)) ? 1 : 0; }
            if (rank >= 4) { v[0] = -INFINITY; v[1] = -INFINITY; v[2] = -INFINITY; v[3] = -INFINITY; }
            int my_e = 0; float my_s = 0.f, ssum = 0.f;
#pragma unroll
            for (int k = 0; k < 8; ++k) {
                const float mx = wave_max_uniform(fmaxf(fmaxf(v[0], v[1]), fmaxf(v[2], v[3])));
                int best = 1 << 20;
#pragma unroll
                for (int j = 0; j < 4; ++j) { const unsigned long long bal = __ballot(v[j] == mx); const int cand = bal ? (4 * (int)__builtin_ctzll(bal) + j) : (1 << 20); best = cand < best ? cand : best; }
                const int wj = best & 3, wl = best >> 2;
                const float sel = wj == 0 ? s[0] : wj == 1 ? s[1] : wj == 2 ? s[2] : s[3];
                const float sw = __builtin_bit_cast(float, __builtin_amdgcn_readlane(__builtin_bit_cast(int, sel), wl));
                const bool mine = lane == wl;
#pragma unroll
                for (int j = 0; j < 4; ++j) v[j] = (mine && wj == j) ? -INFINITY : v[j];
                my_e = lane == k ? best : my_e; my_s = lane == k ? sw : my_s; ssum += sw;
            }
            if (lane < 8) { top_e[(size_t)t * 8 + lane] = my_e; top_w[(size_t)t * 8 + lane] = my_s / ssum * 2.5f; __hip_atomic_fetch_add(&lhist[my_e], 1, __ATOMIC_RELAXED, __HIP_MEMORY_SCOPE_WORKGROUP); }
            asm volatile("s_waitcnt vmcnt(0)" ::: "memory");
            cv_finish(ca, ra, scr, lane); cv_finish(cb, rbuf, scr, lane);
        }
        __syncthreads();
        if (tid_ < 256) { const int c = lhist[tid_]; if (c) atomicAdd(F.ctl + CW_CNT + tid_, (unsigned)c); }
        __syncthreads();
    }
    for (; cv_next < CV_ITEMS; cv_next += cv_stride) { float r0[32]; const CvItem c = cv_decode(F, cv_next, lane); cv_load(c, r0); asm volatile("s_waitcnt vmcnt(0)" ::: "memory"); cv_finish(c, r0, scr, lane); }
}

__device__ __forceinline__ char* slot_addr(unsigned char* ws, float* out, int s, int t) {
    if (s < 4) return (char*)out + (size_t)t * 4096 + (size_t)s * 1024;
    if (s < 8) return (char*)ws + WS_W13 + (size_t)(s - 4) * 64 * MiB + (size_t)t * 1024;
    return (char*)ws + WS_LOGIT + (size_t)t * 1024;
}

__device__ __forceinline__ void lists_phase(Frame& F) {
    const int tid_ = opaque_tid();
    LAS int* seg_start = (LAS int*)F.lds;
    LAS int* seg_cnt = seg_start + 264;
    LAS int* lhist = seg_cnt + 264;
    LAS int* gbase = lhist + 256;
    const int* top_e = (const int*)(F.ws + WS_TOPE); const float* top_w = (const float*)(F.ws + WS_TOPW);
    int* row_src = (int*)(F.ws + WS_ROWSRC); float* row_w = (float*)(F.ws + WS_ROWW); unsigned long long* row_ptr = (unsigned long long*)(F.ws + WS_ROWPTR); int* panel_e = (int*)(F.ws + WS_PANEL);
    for (int v = tid_; v < NSEG; v += 512) seg_cnt[v] = v == 256 ? NTOK : (int)__hip_atomic_load(F.ctl + CW_CNT + v, __ATOMIC_RELAXED, __HIP_MEMORY_SCOPE_AGENT);
    __syncthreads();
    if (tid_ == 0) { int acc = 0; for (int v = 0; v < NSEG; ++v) { seg_start[v] = acc; acc += (*(volatile LAS int*)(seg_cnt + v) + 255) & ~255; } seg_start[NSEG] = acc;
        if (blockIdx.x == 0) ST_WT(F.ctl + CW_PT, (unsigned)(acc >> 8)); }
    __syncthreads();
    for (int v = F.vcu; v < NSEG; v += F.G) {
        const int s0 = seg_start[v], cnt = seg_cnt[v], s1 = seg_start[v + 1];
        for (int rr = s0 + cnt + tid_; rr < s1; rr += 512) { ST_WT(row_src + rr, 0); ST_WT(row_w + rr, 0.f); ST_WT(row_ptr + rr, (unsigned long long)(F.ws + WS_DUMP + (size_t)(rr & 1023) * 2048)); }
        for (int p = (s0 >> 8) + tid_; p < (s1 >> 8); p += 512) ST_WT(panel_e + p, v);
    }
    for (int i = F.vcu * 512 + tid_; i < NTOK; i += F.G * 512) { const int rr = seg_start[256] + i;
        ST_WT(row_src + rr, i); ST_WT(row_w + rr, SLOT_SCALE); ST_WT(row_ptr + rr, (unsigned long long)slot_addr(F.ws, F.out, 8, i)); }
    for (int chunk = F.vcu; chunk < NTOK / 256; chunk += F.G) {
        if (tid_ < 256) lhist[tid_] = 0;
        __syncthreads();
        int e4[4], lr[4];
#pragma unroll
        for (int k = 0; k < 4; ++k) { const int a = chunk * 2048 + tid_ * 4 + k; e4[k] = top_e[a]; lr[k] = __hip_atomic_fetch_add(&lhist[e4[k]], 1, __ATOMIC_RELAXED, __HIP_MEMORY_SCOPE_WORKGROUP); }
        __syncthreads();
        if (tid_ < 256) { const int c = lhist[tid_]; gbase[tid_] = c ? (int)atomicAdd(F.ctl + CW_CUR + tid_, (unsigned)c) : 0; }
        __syncthreads();
#pragma unroll
        for (int k = 0; k < 4; ++k) { const int a = chunk * 2048 + tid_ * 4 + k, tok = a >> 3, slot = a & 7;
            const int rr = seg_start[e4[k]] + gbase[e4[k]] + lr[k];
            ST_WT(row_src + rr, tok); ST_WT(row_w + rr, top_w[a] * SLOT_SCALE); ST_WT(row_ptr + rr, (unsigned long long)slot_addr(F.ws, F.out, slot, tok)); }
        __syncthreads();
    }
}

constexpr int DN_RING = 0, DN_NSLOT = 6, DN_SLOT = 16384, DN_STG = DN_NSLOT * DN_SLOT, DN_STG_ROW = 144, DN_STG_WAVE = 32 * DN_STG_ROW, DN_TOUCH = DN_STG + 8 * DN_STG_WAVE;
static_assert(DN_TOUCH + 8 * 256 <= MISC_OFF, "down-phase LDS map");
__device__ __forceinline__ int dn_colperm(int s) { return 16 * ((s >> 2) & 1) + (s & 3) + 4 * (s >> 3); }
#define DN_LDSRD(dst, addr, off) asm volatile("ds_read_b128 %0, %1 offset:%2" : "=v"(dst) : "v"(addr), "n"(off))
#define DN_DRAIN(ACC, t, dst) do { _Pragma("unroll") for (int m_ = 2 * (t); m_ < 2 * (t) + 2; ++m_) { const int j_ = m_ >> 1, h_ = m_ & 1; const float x0_ = ACC[4 * j_ + 2 * h_] * rw, x1_ = ACC[4 * j_ + 2 * h_ + 1] * rw; \
            ow[j_] = h_ ? __builtin_amdgcn_cvt_pk_fp8_f32(x0_, x1_, ow[j_], true) : __builtin_amdgcn_cvt_pk_fp8_f32(x0_, x1_, ow[j_], false); asm volatile("" : "+v"(ow[j_])); } \
        if ((t) == 3) { u32x4 o_; o_.x = (unsigned)ow[0]; o_.y = (unsigned)ow[1]; o_.z = (unsigned)ow[2]; o_.w = (unsigned)ow[3]; *(LAS u32x4*)(dst) = o_; } } while (0)
#define DN_MFMA(ACC, t, FIRSTSTEP) do { const i32x8 wa_ = __builtin_shufflevector(__builtin_bit_cast(i32x4, W[2 * (t)]), __builtin_bit_cast(i32x4, W[2 * (t) + 1]), 0, 1, 2, 3, 4, 5, 6, 7); \
        if (FIRSTSTEP) { f32x16 z_; _Pragma("unroll") for (int q_ = 0; q_ < 16; ++q_) z_[q_] = 0.f; \
            ACC = __builtin_amdgcn_mfma_scale_f32_32x32x64_f8f6f4(wa_, __builtin_bit_cast(i32x8, hq[t]), z_, 0, 0, 0, 0x7F7F7F7F, 0, 0x7F7F7F7F); wkeep = wa_; } \
        else ACC = __builtin_amdgcn_mfma_scale_f32_32x32x64_f8f6f4(wa_, __builtin_bit_cast(i32x8, hq[t]), ACC, 0, 0, 0, 0x7F7F7F7F, 0, 0x7F7F7F7F); } while (0)
template <bool FIRST, int PAR, bool FLUSH>
__device__ __forceinline__ void dn_chunk(const char* nsrc, f32x16& accA, f32x16& accB, u32x4 (&W)[8], const u32x8 (&hq)[4], LAS unsigned char* lds, unsigned (&a)[8], int& rs,
                                         const float rw, LAS unsigned char* stg_t0, const unsigned stg_ra, GAS char* (&gq)[4], const bool (&ok)[4], const unsigned (&dsrc)[2], const int w) {
    {
        int ow[4] = {0, 0, 0, 0}; i32x8 wkeep;
#pragma unroll
        for (int t = 0; t < 4; ++t) {
            asm volatile("s_waitcnt lgkmcnt(6)" : "+v"(W[2 * t]), "+v"(W[2 * t + 1]));
            DN_MFMA(accA, t, t == 0);
            DN_LDSRD(W[2 * t], a[2 * t], 8192); DN_LDSRD(W[2 * t + 1], a[2 * t + 1], 8192);
            if (t == 0) asm volatile("" : "+v"(accA) : "v"(wkeep));
            if (!FIRST) DN_DRAIN(accB, t, stg_t0 + 64 * (PAR ^ 1) + 32);
            __builtin_amdgcn_sched_barrier(0);
        }
    }
    {
        asm volatile("s_waitcnt vmcnt(8) lgkmcnt(0)" : "+v"(W[0]), "+v"(W[1]), "+v"(W[2]), "+v"(W[3]), "+v"(W[4]), "+v"(W[5]), "+v"(W[6]), "+v"(W[7]) :: "memory");
        __builtin_amdgcn_s_barrier(); asm volatile("" ::: "memory");
        LAS unsigned char* const dd = lds + DN_RING + rs * DN_SLOT + 2 * w * 1024;
        const unsigned dl = (unsigned)(rs == DN_NSLOT - 1 ? -(DN_NSLOT - 1) * DN_SLOT : DN_SLOT); rs = rs == DN_NSLOT - 1 ? 0 : rs + 1;
#pragma unroll
        for (int j = 0; j < 8; ++j) a[j] += dl;
        __builtin_amdgcn_sched_barrier(0);
        int ow[4] = {0, 0, 0, 0}; i32x8 wkeep;
        u32x4 fv0 = {0u, 0u, 0u, 0u}, fv1 = {0u, 0u, 0u, 0u}, fv2 = {0u, 0u, 0u, 0u}, fv3 = {0u, 0u, 0u, 0u};
#pragma unroll
        for (int t = 0; t < 4; ++t) {
            DN_MFMA(accB, t, t == 0);
            DN_LDSRD(W[2 * t], a[2 * t], 0); DN_LDSRD(W[2 * t + 1], a[2 * t + 1], 0);
            if (t == 0) asm volatile("" : "+v"(accB) : "v"(wkeep));
            if (t < 2) __builtin_amdgcn_global_load_lds((const unsigned*)(nsrc + dsrc[t]), (LAS unsigned*)(dd + t * 1024), 16, 0, 0);
            if (FLUSH && t == 0) { DN_LDSRD(fv0, stg_ra, 0); DN_LDSRD(fv1, stg_ra, 8 * DN_STG_ROW); DN_LDSRD(fv2, stg_ra, 16 * DN_STG_ROW); DN_LDSRD(fv3, stg_ra, 24 * DN_STG_ROW); }
            DN_DRAIN(accA, t, stg_t0 + 64 * PAR);
            if (FLUSH && t == 2) { asm volatile("s_waitcnt lgkmcnt(4)" : "+v"(fv0), "+v"(fv1)); if (ok[0]) *(GAS u32x4*)gq[0] = fv0; if (ok[1]) *(GAS u32x4*)gq[1] = fv1; }
            if (FLUSH && t == 3) { asm volatile("s_waitcnt lgkmcnt(4)" : "+v"(fv2), "+v"(fv3)); if (ok[2]) *(GAS u32x4*)gq[2] = fv2; if (ok[3]) *(GAS u32x4*)gq[3] = fv3;
                                   gq[0] += 128; gq[1] += 128; gq[2] += 128; gq[3] += 128; }
            __builtin_amdgcn_sched_barrier(0);
        }
    }
}
__device__ __forceinline__ void down_phase(Frame& F, int p0, int np) {
    const int tid_ = opaque_tid(), lane = tid_ & 63, w = __builtin_amdgcn_readfirstlane(tid_ >> 6), r32 = lane & 31, hi = lane >> 5;
    const unsigned char* H = F.ws + WS_H; const char* WD = (const char*)(F.ws + WS_WD);
    const int* panel_e = (const int*)(F.ws + WS_PANEL); const unsigned long long* row_ptr = (const unsigned long long*)(F.ws + WS_ROWPTR); const float* row_w = (const float*)(F.ws + WS_ROWW);
    LAS unsigned char* lds = F.lds;
    LAS unsigned char* stg = lds + DN_STG + w * DN_STG_WAVE;
    LAS unsigned char* stg_t0 = stg + r32 * DN_STG_ROW + 16 * hi;
    const unsigned stg_ra = (unsigned)(size_t)(stg + (lane >> 3) * DN_STG_ROW + (lane & 7) * 16);
    unsigned dsrc[2];
#pragma unroll
    for (int j = 0; j < 2; ++j) { const int sg = 8 * w + 4 * j + (lane >> 4), su = lane & 15, u = su ^ (sg & 15); dsrc[j] = (unsigned)((32 * (sg >> 5) + dn_colperm(sg & 31)) * 256 + u * 16); }
    unsigned a[8];
#pragma unroll
    for (int f = 0; f < 8; ++f) a[f] = (unsigned)(size_t)lds + (unsigned)(DN_RING + r32 * 256 + (((4 * (f >> 1) + 2 * hi + (f & 1)) ^ (r32 & 15)) * 16));
    int p = p0 + F.vcu;
    if (p < p0 + np) {
        int rs = 0;
        const char* Wb = WD + (size_t)__builtin_amdgcn_readfirstlane(panel_e[p]) * (DM * EDIM);
        asm volatile("" ::: "memory"); __builtin_amdgcn_sched_barrier(0);
#pragma unroll
        for (int c = 0; c < DN_NSLOT; ++c)
#pragma unroll
            for (int j = 0; j < 2; ++j) __builtin_amdgcn_global_load_lds((const unsigned*)(Wb + (size_t)c * DN_SLOT + dsrc[j]), (LAS unsigned*)(lds + DN_RING + c * DN_SLOT + (2 * w + j) * 1024), 16, 0, 0);
        __builtin_amdgcn_sched_barrier(0);
        asm volatile("s_waitcnt vmcnt(10)" ::: "memory");
        __builtin_amdgcn_s_barrier(); asm volatile("" ::: "memory");
        u32x4 W[8];
#pragma unroll
        for (int f = 0; f < 8; ++f) DN_LDSRD(W[f], a[f], 0);
        for (;;) {
            const int pn = p + F.G; const bool more = pn < p0 + np;
            const char* Wbn = WD + (size_t)__builtin_amdgcn_readfirstlane(panel_e[more ? pn : p]) * (DM * EDIM);
            const int row0 = p * 256 + 32 * w;
            u32x8 hq[4];
            { const unsigned char* hrow = H + (size_t)(row0 + r32) * EDIM + hi * 32;
#pragma unroll
                for (int t = 0; t < 4; ++t) hq[t] = *(const u32x8*)(hrow + 64 * t); }
            GAS char* gq[4]; bool ok[4];
#pragma unroll
            for (int k = 0; k < 4; ++k) { GAS char* rp = (GAS char*)row_ptr[row0 + 8 * k + (lane >> 3)]; ok[k] = (size_t)((const unsigned char*)rp - (F.ws + WS_DUMP)) >= (size_t)(2 * MiB); gq[k] = rp + (lane & 7) * 16; }
            const float rw = row_w[row0 + r32] * (1.f / (H_SCALE * WD_SCALE));
            f32x16 accA, accB;
#pragma unroll
            for (int q = 0; q < 16; ++q) { accA[q] = 0.f; accB[q] = 0.f; }
#define DN_NSRC(c) ((c) + DN_NSLOT < 16 ? Wb + (size_t)((c) + DN_NSLOT) * DN_SLOT : Wbn + (size_t)((c) + DN_NSLOT - 16) * DN_SLOT)
            dn_chunk<true, 0, false>(DN_NSRC(0), accA, accB, W, hq, lds, a, rs, rw, stg_t0, stg_ra, gq, ok, dsrc, w);
#pragma unroll 1
            for (int c = 1; c < 15; c += 2) {
                dn_chunk<false, 1, false>(DN_NSRC(c), accA, accB, W, hq, lds, a, rs, rw, stg_t0, stg_ra, gq, ok, dsrc, w);
                if (c == 9)
                    __builtin_amdgcn_global_load_lds((const unsigned*)(H + (size_t)((more ? pn : p) * 256 + 32 * w) * EDIM + lane * 128), (LAS unsigned*)(lds + DN_TOUCH + w * 256), 4, 0, 0);
                dn_chunk<false, 0, true>(DN_NSRC(c + 1), accA, accB, W, hq, lds, a, rs, rw, stg_t0, stg_ra, gq, ok, dsrc, w);
            }
            dn_chunk<false, 1, false>(DN_NSRC(15), accA, accB, W, hq, lds, a, rs, rw, stg_t0, stg_ra, gq, ok, dsrc, w);
#undef DN_NSRC
            { u32x4 o;
                { int w0 = 0, w1 = 0, w2 = 0, w3 = 0;
                  w0 = __builtin_amdgcn_cvt_pk_fp8_f32(accB[0] * rw, accB[1] * rw, w0, false); w0 = __builtin_amdgcn_cvt_pk_fp8_f32(accB[2] * rw, accB[3] * rw, w0, true);
                  w1 = __builtin_amdgcn_cvt_pk_fp8_f32(accB[4] * rw, accB[5] * rw, w1, false); w1 = __builtin_amdgcn_cvt_pk_fp8_f32(accB[6] * rw, accB[7] * rw, w1, true);
                  w2 = __builtin_amdgcn_cvt_pk_fp8_f32(accB[8] * rw, accB[9] * rw, w2, false); w2 = __builtin_amdgcn_cvt_pk_fp8_f32(accB[10] * rw, accB[11] * rw, w2, true);
                  w3 = __builtin_amdgcn_cvt_pk_fp8_f32(accB[12] * rw, accB[13] * rw, w3, false); w3 = __builtin_amdgcn_cvt_pk_fp8_f32(accB[14] * rw, accB[15] * rw, w3, true);
                  o.x = (unsigned)w0; o.y = (unsigned)w1; o.z = (unsigned)w2; o.w = (unsigned)w3; }
                *(LAS u32x4*)(stg_t0 + 64 + 32) = o;
                u32x4 v0, v1, v2, v3; asm volatile("s_waitcnt lgkmcnt(0)" ::: "memory"); DN_LDSRD(v0, stg_ra, 0); DN_LDSRD(v1, stg_ra, 8 * DN_STG_ROW); DN_LDSRD(v2, stg_ra, 16 * DN_STG_ROW); DN_LDSRD(v3, stg_ra, 24 * DN_STG_ROW);
                asm volatile("s_waitcnt lgkmcnt(0)" : "+v"(v0), "+v"(v1), "+v"(v2), "+v"(v3));
                if (ok[0]) *(GAS u32x4*)gq[0] = v0; if (ok[1]) *(GAS u32x4*)gq[1] = v1; if (ok[2]) *(GAS u32x4*)gq[2] = v2; if (ok[3]) *(GAS u32x4*)gq[3] = v3; }
            if (!more) break;
            p = pn; Wb = Wbn;
        }
    }
    asm volatile("s_waitcnt vmcnt(0) lgkmcnt(0)" ::: "memory");
    __builtin_amdgcn_s_barrier(); asm volatile("" ::: "memory");
}
#undef DN_MFMA
#undef DN_DRAIN
#undef DN_LDSRD

__device__ __forceinline__ void combine_phase(Frame& F) {
    const int tid_ = opaque_tid(), lane_ = tid_ & 63, wave_ = __builtin_amdgcn_readfirstlane(tid_ >> 6);
    const bf16_t* x1 = (const bf16_t*)(F.ws + WS_XB);
    const int gw = F.vcu * NWAVES + wave_, NGW = F.G * NWAVES, lane = lane_;
    f32x4 g[4], bb[4];
#pragma unroll
    for (int j = 0; j < 4; ++j) { g[j] = *(const f32x4*)(F.ln2_g + lane * 16 + 4 * j); bb[j] = *(const f32x4*)(F.ln2_b + lane * 16 + 4 * j); }
    for (int t = gw; t < NTOK; t += NGW) {
        float v[16];
        { const u32x4* xr = (const u32x4*)(x1 + (size_t)t * DM) + 2 * lane; const u32x4 a = xr[0], b = xr[1];
            v[0] = ALPHA * bflo(a.x); v[1] = ALPHA * bfhi(a.x); v[2] = ALPHA * bflo(a.y); v[3] = ALPHA * bfhi(a.y); v[4] = ALPHA * bflo(a.z); v[5] = ALPHA * bfhi(a.z); v[6] = ALPHA * bflo(a.w); v[7] = ALPHA * bfhi(a.w);
            v[8] = ALPHA * bflo(b.x); v[9] = ALPHA * bfhi(b.x); v[10] = ALPHA * bflo(b.y); v[11] = ALPHA * bfhi(b.y); v[12] = ALPHA * bflo(b.z); v[13] = ALPHA * bfhi(b.z); v[14] = ALPHA * bflo(b.w); v[15] = ALPHA * bfhi(b.w); }
        float f[16];
#pragma unroll
        for (int i = 0; i < 16; ++i) f[i] = 0.f;
#pragma unroll
        for (int s = 0; s < 9; ++s) { const u32x4 q = __builtin_nontemporal_load((const u32x4*)slot_addr(F.ws, F.out, s, t) + lane);
            const unsigned wv[4] = {q.x, q.y, q.z, q.w};
#pragma unroll
            for (int j = 0; j < 4; ++j) { const f32x2_t lo = __builtin_amdgcn_cvt_pk_f32_fp8((int)wv[j], false), hi2 = __builtin_amdgcn_cvt_pk_f32_fp8((int)wv[j], true);
                f[4 * j] += lo.x; f[4 * j + 1] += lo.y; f[4 * j + 2] += hi2.x; f[4 * j + 3] += hi2.y; } }
        float s = 0.f;
#pragma unroll
        for (int i = 0; i < 16; ++i) { v[i] += f[i] * SLOT_INV; s += v[i]; }
        const float mean = wave_sum(s) * (1.f / DM); float s2 = 0.f;
#pragma unroll
        for (int i = 0; i < 16; ++i) { v[i] -= mean; s2 += v[i] * v[i]; }
        const float rstd = 1.f / sqrtf(wave_sum(s2) * (1.f / DM) + LN_EPS);
        float* orow = F.out + (size_t)t * DM + lane * 16;
#pragma unroll
        for (int j = 0; j < 4; ++j) { f32x4 y; y.x = v[4 * j] * rstd; y.y = v[4 * j + 1] * rstd; y.z = v[4 * j + 2] * rstd; y.w = v[4 * j + 3] * rstd;
            *(f32x4*)(orow + 4 * j) = y * g[j] + bb[j]; }
    }
}

struct Args { const float* in[17]; float* out; unsigned char* ws; };
__global__ void __launch_bounds__(NWAVES * 64, 2) fwd_kernel(Args args) {
    extern __shared__ __attribute__((aligned(16))) unsigned char lds[];
    Frame F;
    F.lds = (LAS unsigned char*)lds;
    F.G = gridDim.x; { const int bx = blockIdx.x; F.vcu = (F.G % 8 == 0) ? (bx % 8) * (F.G / 8) + bx / 8 : bx; }
    F.ws = args.ws; F.out = args.out; F.ctl = (unsigned*)(args.ws + WS_CTL);
    F.x = args.in[0]; F.w_in = args.in[1]; F.conv_w = args.in[2]; F.w_o = args.in[3]; F.ln1_g = args.in[4]; F.ln1_b = args.in[5]; F.rel_bias = args.in[6]; F.w_router = args.in[7]; F.router_bias = args.in[8];
    F.eg = args.in[9]; F.eu = args.in[10]; F.ed = args.in[11]; F.sg = args.in[12]; F.su = args.in[13]; F.sd = args.in[14]; F.ln2_g = args.in[15]; F.ln2_b = args.in[16];
    volatile LAS unsigned* MISC = (volatile LAS unsigned*)(F.lds + MISC_OFF);
    for (int u = threadIdx.x; u < (LDS_BYTES - MISC_OFF) / 4; u += NWAVES * 64) MISC[u] = 0u;
    __syncthreads();
    XcdBarrier bar = xcd_barrier_post(F.ctl + CW_BAR, MISC + 8);
    LAS unsigned char* ring = F.lds;

    p0_prologue(F);
    xcd_barrier(bar);
    { DenseOrder S; S.init(NTOK, PROJW, DM / 2, F.G, (int)blockIdx.x, F.ws + WS_WIN); EpiProj E{(bf16_t*)(F.ws + WS_PROJ), (bf16_t*)(F.ws + WS_CONVIN)};
        pg8::gemm_phase<EpiProj, DenseOrder, true, true>(ring, (const char*)(F.ws + WS_XB), DM / 2, S, E); }
    xcd_barrier(bar);
    if (F.G == 256) {
        constexpr int ATT_GPR = 6;
        unsigned* tctr = F.ctl + CW_TEAM + (F.vcu >> 3) * 64; unsigned tgt = 0;
        for (int r0 = 0; r0 < 12; r0 += ATT_GPR) {
            for (int gi = 0; gi < ATT_GPR; ++gi) attn_pair<0>(F, F.vcu + (r0 + gi) * 256);
            tgt += 8; team_barrier(tctr, tgt);
            for (int gi = 0; gi < ATT_GPR; ++gi) attn_pair<1>(F, F.vcu + (r0 + gi) * 256);
            tgt += 8; team_barrier(tctr, tgt);
            for (int gi = 0; gi < ATT_GPR; ++gi) attn_pair<2>(F, F.vcu + (r0 + gi) * 256);
        }
        conv_phase(F);
        xcd_barrier(bar);
    } else {
        { attn_branch<0>(F); conv_phase(F); }
        xcd_barrier(bar);
        attn_branch<1>(F);
        xcd_barrier(bar);
        attn_branch<2>(F);
        xcd_barrier(bar);
    }
    { DenseOrder S; S.init(NTOK, DM, DM, F.G, (int)blockIdx.x, F.ws + WS_WO); EpiWo E{(bf16_t*)F.out, F.x};
        pg8::gemm_phase<EpiWo, DenseOrder, true>(ring, (const char*)(F.ws + WS_XB), DM, S, E); }
    xcd_barrier(bar);
    ln1_phase(F);
    xcd_barrier(bar);
    { DenseOrder S; S.init(NTOK, NEXP, DM, F.G, (int)blockIdx.x, F.ws + WS_WR); EpiF32 E{(float*)(F.ws + WS_LOGIT), NEXP};
        pg8::gemm_phase<EpiF32, DenseOrder, true>(ring, (const char*)(F.ws + WS_XB), DM, S, E); }
    xcd_barrier(bar);
    route_phase(F);
    xcd_barrier(bar);
    lists_phase(F);
    xcd_barrier(bar);
    const int PT = (int)__hip_atomic_load(F.ctl + CW_PT, __ATOMIC_RELAXED, __HIP_MEMORY_SCOPE_AGENT);
    { MoeOrder S{PT * 2, F.G, F.vcu, 1, 0, DM / 2, (const int*)(F.ws + WS_PANEL), (const int*)(F.ws + WS_ROWSRC), (const char*)(F.ws + WS_W13), (size_t)512 * DM};
        EpiGU E{(unsigned char*)(F.ws + WS_H)};
        pg8::gemm_phase<EpiGU, MoeOrder, true, true>(ring, (const char*)(F.ws + WS_X8), DM / 2, S, E); }
    xcd_barrier(bar);
    down_phase(F, 0, PT);
    xcd_barrier(bar);
    combine_phase(F);
}

extern "C" void kernel_launch(void* const* d_in, const int* in_sizes, int n_in, void* d_out, int out_size, void* d_ws, size_t ws_size, hipStream_t stream) {
    static int grid = 0;
    if (grid == 0) {
        if (n_in != 17 || out_size != NTOK * DM || ws_size < WS_NEED) { fprintf(stderr, "kernel_launch: unexpected problem (n_in %d, out %d, ws %zu)\n", n_in, out_size, ws_size); grid = -1; return; }
        int dev = 0, cus = 0;
        if (hipGetDevice(&dev) != hipSuccess || hipDeviceGetAttribute(&cus, hipDeviceAttributeMultiprocessorCount, dev) != hipSuccess) { grid = -1; return; }
        if (hipFuncSetAttribute((const void*)fwd_kernel, hipFuncAttributeMaxDynamicSharedMemorySize, LDS_BYTES) != hipSuccess) { fprintf(stderr, "kernel_launch: hipFuncSetAttribute failed\n"); grid = -1; return; }
        int per_cu = 0;
        if (hipOccupancyMaxActiveBlocksPerMultiprocessor(&per_cu, (const void*)fwd_kernel, NWAVES * 64, LDS_BYTES) != hipSuccess || per_cu < 1) { fprintf(stderr, "kernel_launch: occupancy query reports %d\n", per_cu); }
        (void)hipGetLastError();
        grid = cus;
    }
    if (grid < 0) return;
    (void)hipMemsetAsync((char*)d_ws + WS_CTL, 0, CTL_ZERO_BYTES, stream);
    Args a{};
    for (int i = 0; i < 17; ++i) a.in[i] = (const float*)d_in[i];
    a.out = (float*)d_out; a.ws = (unsigned char*)d_ws;
    hipLaunchKernelGGL(fwd_kernel, dim3(grid), dim3(NWAVES * 64), LDS_BYTES, stream, a);
}
```

```cpp
#include <hip/hip_runtime.h>
#include <cstdio>
#include <cstdint>
#include <cmath>

#define GAS __attribute__((address_space(1)))
#define LAS __attribute__((address_space(3)))
typedef unsigned short bf16_t;
typedef short bf16x8 __attribute__((ext_vector_type(8)));
typedef short s16x4 __attribute__((ext_vector_type(4)));
typedef float f32x4 __attribute__((ext_vector_type(4)));
typedef float f32x16 __attribute__((ext_vector_type(16)));
typedef unsigned u32x4 __attribute__((ext_vector_type(4)));
typedef int i32x8 __attribute__((ext_vector_type(8)));
typedef int i32x4 __attribute__((ext_vector_type(4)));
typedef unsigned u32x8 __attribute__((ext_vector_type(8)));
typedef unsigned u32x2 __attribute__((ext_vector_type(2)));
typedef float f32x2_t __attribute__((ext_vector_type(2)));
typedef __bf16 bf16x2_t __attribute__((ext_vector_type(2)));
typedef short v4i16_t __attribute__((ext_vector_type(4)));

__device__ __forceinline__ unsigned cvtpk(float lo, float hi) { f32x2_t v = {lo, hi}; bf16x2_t b = __builtin_convertvector(v, bf16x2_t); return __builtin_bit_cast(unsigned, b); }
__device__ __forceinline__ float bflo(unsigned u) { return __builtin_bit_cast(float, u << 16); }
__device__ __forceinline__ float bfhi(unsigned u) { return __builtin_bit_cast(float, u & 0xffff0000u); }

__device__ __forceinline__ int opaque_tid() { int t = threadIdx.x; asm volatile("" : "+v"(t)); return t; }
namespace pg8 {
constexpr int BM = 256, BK = 64, HALF = 128, HTB = HALF * BK * 2, STAGE_BYTES = 8 * HTB;
__host__ __device__ __forceinline__ int lds_byte(int r, int c) { const int st = (r >> 4) * 2 + (c >> 5), rr = r & 15, cc = c & 31, ob = rr * 64 + cc * 2; return st * 1024 + (ob ^ (((ob >> 9) & 1) << 5)); }
__host__ __device__ __forceinline__ void stage_rc(int b, int& R, int& C) { const int st = b / 1024, sb = b % 1024, swz = sb ^ (((sb >> 9) & 1) << 5); R = (st >> 1) * 16 + swz / 64; C = (st & 1) * 32 + (swz % 64) / 2; }
__host__ __device__ __forceinline__ int perm32(int rho) { const int n = rho >> 4, i = rho & 15; return 8 * (i >> 2) + 4 * n + (i & 3); }

struct Unit { int pm, pn, aux; };

template <class Epi, class Sched, bool ALIGN_EPI, bool F8 = false>
__device__ __forceinline__ void gemm_phase(LAS unsigned char* lds, const char* Abase, const int K, const Sched& S, const Epi& E) {
    const int tid = opaque_tid(), wid = __builtin_amdgcn_readfirstlane(tid >> 6), lane = tid & 63, wr = wid >> 2, wc = wid & 3, fr = lane & 15, fq = lane >> 4;
    const int nt = K / BK;
    int RA[2], CA[2]; unsigned voffB[2];
#pragma unroll
    for (int i = 0; i < 2; ++i) { int R, C; stage_rc(tid * 16 + i * 8192, R, C); const int Rb = Epi::PERM ? ((R & ~31) + perm32(R & 31)) : R; RA[i] = R; CA[i] = C; voffB[i] = (unsigned)(Rb * K + C) * 2u; }
    const size_t kstep = (size_t)(BK * 2);
    const size_t hstepB = (size_t)HALF * K * 2;
    const unsigned ldsw = (unsigned)wid * 1024u;
    const int aoff = lds_byte(wr * 64 + fr, fq * 8), boff = lds_byte(wc * 32 + fr, fq * 8);
#define PG8_SA(b, h) (((b) * 2 + (h)) * HTB)
#define PG8_SB(b, h) ((4 + (b) * 2 + (h)) * HTB)
#define PG8_STAGE_B(bufoff, gbase) do { _Pragma("unroll") for (int _i = 0; _i < 2; ++_i) \
        __builtin_amdgcn_global_load_lds((const unsigned*)((const char*)(gbase) + voffB[_i]), (LAS unsigned*)(lds + (bufoff) + ldsw + _i * 8192), 16, 0, 0); } while (0)
#define PG8_STAGE_A(bufoff, kptr, vo, h) do { _Pragma("unroll") for (int _i = 0; _i < 2; ++_i) \
        __builtin_amdgcn_global_load_lds((const unsigned*)((const char*)(kptr) + (vo)[h][_i]), (LAS unsigned*)(lds + (bufoff) + ldsw + _i * 8192), 16, 0, 0); } while (0)
#define PG8_LDA(dst, b, h) do { _Pragma("unroll") for (int m = 0; m < 4; ++m) { if constexpr (F8) { const u32x4 lo_ = *(const LAS u32x4*)(lds + PG8_SA(b, h) + aoff + m * 2048), hi_ = *(const LAS u32x4*)(lds + PG8_SA(b, h) + aoff + m * 2048 + 1024); \
            dst##8[m] = __builtin_shufflevector(lo_, hi_, 0, 1, 2, 3, 4, 5, 6, 7); } \
        else { _Pragma("unroll") for (int k = 0; k < 2; ++k) dst[m][k] = *(const LAS bf16x8*)(lds + PG8_SA(b, h) + aoff + m * 2048 + k * 1024); } } } while (0)
#define PG8_LDB(dst, b, h) do { _Pragma("unroll") for (int n = 0; n < 2; ++n) { if constexpr (F8) { const u32x4 lo_ = *(const LAS u32x4*)(lds + PG8_SB(b, h) + boff + n * 2048), hi_ = *(const LAS u32x4*)(lds + PG8_SB(b, h) + boff + n * 2048 + 1024); \
            dst##8[n] = __builtin_shufflevector(lo_, hi_, 0, 1, 2, 3, 4, 5, 6, 7); } \
        else { _Pragma("unroll") for (int k = 0; k < 2; ++k) dst[n][k] = *(const LAS bf16x8*)(lds + PG8_SB(b, h) + boff + n * 2048 + k * 1024); } } } while (0)
#define PG8_MMA(ai, bj, At, Bt) do { __builtin_amdgcn_s_setprio(1); _Pragma("unroll") for (int m = 0; m < 4; ++m) _Pragma("unroll") for (int n = 0; n < 2; ++n) { \
        if constexpr (F8) asm volatile("v_mfma_scale_f32_16x16x128_f8f6f4 %0, %1, %2, %0, %3, %3 op_sel_hi:[0,0,0]" : "+v"(acc[ai][bj][m][n]) : "v"(Bt##8[n]), "v"(At##8[m]), "v"(f8one)); \
        else { _Pragma("unroll") for (int k = 0; k < 2; ++k) acc[ai][bj][m][n] = __builtin_amdgcn_mfma_f32_16x16x32_bf16(Bt[n][k], At[m][k], acc[ai][bj][m][n], 0, 0, 0); } } \
        __builtin_amdgcn_s_setprio(0); } while (0)
#define PG8_WAIT_V(n) asm volatile("s_waitcnt vmcnt(" #n ")" ::: "memory")
#define PG8_WAIT_L(n) asm volatile("s_waitcnt lgkmcnt(" #n ")" ::: "memory")
#define PG8_BAR __builtin_amdgcn_s_barrier()
#define PG8_SCHED __builtin_amdgcn_sched_barrier(0)
    Unit cur, nxt; int ui = 0;
    if (!S.next(0, cur)) return;
    f32x4 acc[2][2][4][2];
#pragma unroll
    for (int a = 0; a < 2; ++a)
#pragma unroll
        for (int b = 0; b < 2; ++b)
#pragma unroll
            for (int m = 0; m < 4; ++m)
#pragma unroll
                for (int n = 0; n < 2; ++n) acc[a][b][m][n] = (f32x4){0.f, 0.f, 0.f, 0.f};
    bf16x8 At[4][2], B0[2][2], B1[2][2];
    u32x8 At8[4], B08[2], B18[2];
    int f8one = 0x7F7F7F7F; asm volatile("" : "+v"(f8one));
    unsigned vc[2][2], vn[2][2];
    S.a_off(cur, RA, CA, vc);
    const char* cB = S.b_base(cur);
    PG8_STAGE_B(PG8_SB(0, 0), cB); PG8_STAGE_B(PG8_SB(0, 1), cB + hstepB); PG8_STAGE_A(PG8_SA(0, 0), Abase, vc, 0); PG8_STAGE_A(PG8_SA(0, 1), Abase, vc, 1);
    if (wr == 1) PG8_BAR;
    PG8_WAIT_V(2); PG8_BAR;
    PG8_STAGE_B(PG8_SB(1, 0), cB + kstep); PG8_STAGE_A(PG8_SA(1, 0), Abase + kstep, vc, 0); PG8_STAGE_B(PG8_SB(1, 1), cB + hstepB + kstep);
    PG8_WAIT_V(6); PG8_BAR;
    for (;;) {
        const bool has_next = S.next(ui + 1, nxt);
        const char* nB = cB;
        if (has_next) { S.a_off(nxt, RA, CA, vn); nB = S.b_base(nxt); }
        else {
#pragma unroll
            for (int h = 0; h < 2; ++h)
#pragma unroll
                for (int i = 0; i < 2; ++i) vn[h][i] = vc[h][i];
        }
#pragma unroll 1
        for (int t = 0; t < nt; t += 2) {
            const bool last = (t == nt - 2);
            const char* ka1 = Abase + (size_t)(t + 1) * kstep;
            const char* ka2 = last ? Abase : Abase + (size_t)(t + 2) * kstep;
            const char* ka3 = ka2 + kstep;
            const char* b2 = last ? nB : cB + (size_t)(t + 2) * kstep;
            const char* b3 = b2 + kstep;
            unsigned v2[2][2];
#pragma unroll
            for (int h = 0; h < 2; ++h)
#pragma unroll
                for (int i = 0; i < 2; ++i) v2[h][i] = last ? vn[h][i] : vc[h][i];
            PG8_LDB(B0, 0, 0); PG8_LDB(B1, 0, 1); PG8_SCHED; PG8_LDA(At, 0, 0); PG8_STAGE_A(PG8_SA(1, 1), ka1, vc, 1);
            PG8_WAIT_V(8); PG8_WAIT_L(0); PG8_BAR; PG8_MMA(0, 0, At, B0); PG8_MMA(0, 1, At, B1); PG8_BAR; PG8_SCHED;
            PG8_LDA(At, 0, 1); PG8_STAGE_B(PG8_SB(0, 0), b2); PG8_STAGE_B(PG8_SB(0, 1), b2 + hstepB); PG8_STAGE_A(PG8_SA(0, 0), ka2, v2, 0);
            PG8_WAIT_V(8); PG8_WAIT_L(0); PG8_BAR; PG8_MMA(1, 0, At, B0); PG8_MMA(1, 1, At, B1); PG8_BAR; PG8_SCHED;
            PG8_LDB(B0, 1, 0); PG8_LDB(B1, 1, 1); PG8_SCHED; PG8_LDA(At, 1, 0); PG8_STAGE_A(PG8_SA(0, 1), ka2, v2, 1);
            PG8_WAIT_V(8); PG8_WAIT_L(0); PG8_BAR; PG8_MMA(0, 0, At, B0); PG8_MMA(0, 1, At, B1); PG8_BAR; PG8_SCHED;
            PG8_LDA(At, 1, 1); PG8_STAGE_B(PG8_SB(1, 0), b3); PG8_STAGE_B(PG8_SB(1, 1), b3 + hstepB); PG8_STAGE_A(PG8_SA(1, 0), ka3, v2, 0);
            PG8_WAIT_V(8); PG8_WAIT_L(0); PG8_BAR; PG8_MMA(1, 0, At, B0); PG8_MMA(1, 1, At, B1); PG8_BAR; PG8_SCHED;
        }
        if constexpr (F8) asm volatile("s_nop 15\n\ts_nop 15" ::: "memory");
        if constexpr (ALIGN_EPI) { if (wr == 0) PG8_BAR; }
        E(acc, cur, wr, wc, fr, fq);
        if (!has_next) break;
#pragma unroll
        for (int a = 0; a < 2; ++a)
#pragma unroll
            for (int b = 0; b < 2; ++b)
#pragma unroll
                for (int m = 0; m < 4; ++m)
#pragma unroll
                    for (int n = 0; n < 2; ++n) acc[a][b][m][n] = (f32x4){0.f, 0.f, 0.f, 0.f};
        cur = nxt; cB = nB; ++ui;
#pragma unroll
        for (int h = 0; h < 2; ++h)
#pragma unroll
            for (int i = 0; i < 2; ++i) vc[h][i] = vn[h][i];
        if constexpr (ALIGN_EPI) { if (wr == 1) PG8_BAR; }
    }
    PG8_WAIT_V(0);
    if constexpr (!ALIGN_EPI) { if (wr == 0) PG8_BAR; }
    PG8_BAR;
#undef PG8_SA
#undef PG8_SB
#undef PG8_STAGE_A
#undef PG8_STAGE_B
#undef PG8_LDA
#undef PG8_LDB
#undef PG8_MMA
#undef PG8_WAIT_V
#undef PG8_WAIT_L
#undef PG8_BAR
#undef PG8_SCHED
}
}

constexpr int DM = 1024, SEQ = 2048, NTOK = 65536, PROJW = 3072, NH = 12, NEXP = 256, EDIM = 256;
constexpr int HALF_TOK = NTOK / 2;
constexpr float SLOT_SCALE = 16.f, SLOT_INV = 1.f / 16.f;
constexpr float X_SCALE = 4.f, W13_SCALE = 16.f;
constexpr float ALPHA = 1.189207115002721f, LN_EPS = 1e-5f, LOG2E = 1.4426950408889634f;
constexpr int NWAVES = 8;

constexpr size_t MiB = (size_t)1 << 20;
constexpr size_t WS_CTL = 0, CTL_ZERO_BYTES = 1 * MiB;
constexpr size_t WS_BIAS = 1 * MiB;
constexpr size_t WS_WIN = 2 * MiB;
constexpr size_t WS_WO = 8 * MiB;
constexpr size_t WS_WR = 10 * MiB;
constexpr size_t WS_W13 = 12 * MiB;
constexpr size_t WS_WD = 269 * MiB;
constexpr size_t WS_XB = 398 * MiB;
constexpr size_t WS_PROJ = 526 * MiB;
constexpr size_t WS_CONVIN = WS_PROJ + 288 * MiB;
constexpr size_t WS_LSE = 910 * MiB;
constexpr size_t WS_LOGIT = 526 * MiB;
constexpr size_t WS_TOPE = 590 * MiB;
constexpr size_t WS_TOPW = 592 * MiB;
constexpr size_t WS_ROWSRC = 594 * MiB;
constexpr size_t WS_ROWW = 597 * MiB;
constexpr size_t WS_H = 600 * MiB;
constexpr size_t WS_ROWPTR = 952 * MiB;
constexpr size_t WS_PANEL = 958 * MiB;
constexpr size_t WS_X8 = 768 * MiB;
constexpr size_t WS_DUMP = 976 * MiB;
constexpr size_t WS_NEED = 1024 * MiB;
constexpr int MAXROWS = NTOK * 8 + 256 * 255 + NTOK;
constexpr int MAXPANELS = MAXROWS / 256;
static_assert((size_t)MAXROWS * 512 <= 320 * MiB && (size_t)MAXROWS * 8 <= 6 * MiB && (size_t)MAXROWS * 4 <= 3 * MiB, "ws map");
constexpr int NSEG = 257;
constexpr int CW_BAR = 4096, CW_CNT = 16384, CW_CUR = 17408, CW_PT = 18433, CW_TEAM = 20480;

constexpr int RING_BYTES = 143360;
constexpr int ATT_HALF = 71680, ATT_K = 0, ATT_V = 36864, ATT_TBL = 69632, ATT_SC = 70400;
constexpr int MISC_OFF = RING_BYTES;
constexpr int LDS_BYTES = 147456;

#define ST_WT(p, v) __hip_atomic_store((p), (v), __ATOMIC_RELAXED, __HIP_MEMORY_SCOPE_AGENT)
#define LDS_WAIT() asm volatile("s_waitcnt lgkmcnt(0)" ::: "memory")
#define VM_WAIT() asm volatile("s_waitcnt vmcnt(0)" ::: "memory")

#define XB_TMO      128
#define XB_XCNT(j)  (256  + 64 * (j))
#define XB_XSUB(j)  (1280 + 64 * (j))
#define XB_XGEN(j)  (2304 + 64 * (j))
#define XB_TOP      3328
#define XB_TOPGEN   3392
#define XCD_BAR_WORDS 3456
#define XB_SPIN_CAP (1u << 18)
__device__ __forceinline__ unsigned xb_ld(unsigned* p)              { return __hip_atomic_load(p, __ATOMIC_RELAXED, __HIP_MEMORY_SCOPE_AGENT); }
__device__ __forceinline__ unsigned xb_add(unsigned* p, unsigned v) { return __hip_atomic_fetch_add(p, v, __ATOMIC_RELAXED, __HIP_MEMORY_SCOPE_AGENT); }
__device__ __forceinline__ unsigned xb_xcc_id() { return (unsigned)__builtin_amdgcn_s_getreg((3 << 11) | 20) & 0xFu; }
#define XB_SPIN(cond, bar) do { unsigned _sp = 0; while (cond) { __builtin_amdgcn_s_sleep(1); \
    if ((++_sp & 255u) == 0u) { if (xb_ld(&(bar)[XB_TMO])) break; if (_sp > XB_SPIN_CAP) { atomicAdd(&(bar)[XB_TMO], 1u); break; } } } } while (0)
struct XcdBarrier { unsigned* bar; unsigned x; volatile LAS unsigned* st; };
__device__ __forceinline__ XcdBarrier xcd_barrier_post(unsigned* bar, volatile LAS unsigned* st) {
    XcdBarrier b; b.bar = bar; b.x = xb_xcc_id(); b.st = st;
    if (threadIdx.x == 0) (void)xb_add(&bar[XB_XCNT(b.x)], 1u);
    return b;
}
__device__ __forceinline__ void xcd_barrier_complete(unsigned* bar, unsigned x, unsigned& nloc, unsigned& nx) {
    const unsigned G = gridDim.x * gridDim.y * gridDim.z;
    unsigned sum, cnt, mine, sp = 0u;
    for (;;) {
        sum = 0u; cnt = 0u; mine = 0u;
#pragma unroll
        for (unsigned j = 0; j < 16; ++j) { const unsigned c = xb_ld(&bar[XB_XCNT(j)]); sum += c; cnt += (c > 0u) ? 1u : 0u; mine = (j == x) ? c : mine; }
        if (sum == G) break;
        __builtin_amdgcn_s_sleep(1);
        if ((++sp & 255u) == 0u) { if (xb_ld(&bar[XB_TMO])) break; if (sp > XB_SPIN_CAP) { atomicAdd(&bar[XB_TMO], 1u); break; } }
    }
    nloc = mine > 0u ? mine : 1u; nx = cnt > 0u ? cnt : 1u;
}
__device__ __forceinline__ void xcd_barrier(const XcdBarrier& b) {
    asm volatile("s_waitcnt vmcnt(0)" ::: "memory");
    __syncthreads();
    if (threadIdx.x == 0) {
        unsigned* bar = b.bar;
        __builtin_amdgcn_s_waitcnt(0);
        unsigned nloc = b.st[0], nx = b.st[1];
        if (nloc == 0u) { xcd_barrier_complete(bar, b.x, nloc, nx); b.st[0] = nloc; b.st[1] = nx; }
        const unsigned old = xb_add(&bar[XB_XSUB(b.x)], 1u);
        const unsigned gen = old / nloc;
        if (old + 1u == (gen + 1u) * nloc) {
            __builtin_amdgcn_fence(__ATOMIC_RELEASE, "agent");
            asm volatile("s_waitcnt vmcnt(0)" ::: "memory");
            const unsigned og = xb_add(&bar[XB_TOP], 1u);
            const unsigned tg = og / nx;
            if (og + 1u == (tg + 1u) * nx) xb_add(&bar[XB_TOPGEN], 1u);
            else XB_SPIN(xb_ld(&bar[XB_TOPGEN]) == tg, bar);
            __builtin_amdgcn_fence(__ATOMIC_ACQUIRE, "agent");
            xb_add(&bar[XB_XGEN(b.x)], 1u);
            asm volatile("s_waitcnt vmcnt(0)" ::: "memory");
        } else {
            XB_SPIN(xb_ld(&bar[XB_XGEN(b.x)]) == gen, bar);
            __builtin_amdgcn_fence(__ATOMIC_ACQUIRE, "agent");
            asm volatile("s_waitcnt vmcnt(0)" ::: "memory");
        }
    }
    __syncthreads();
}

__device__ __forceinline__ void team_barrier(unsigned* ctr, unsigned target) {
    asm volatile("s_waitcnt vmcnt(0)" ::: "memory");
    __syncthreads();
    if (threadIdx.x == 0) {
        __builtin_amdgcn_fence(__ATOMIC_RELEASE, "agent");
        asm volatile("s_waitcnt vmcnt(0)" ::: "memory");
        (void)xb_add(ctr, 1u);
        for (unsigned sp = 0; xb_ld(ctr) < target && sp < (1u << 24); ++sp) __builtin_amdgcn_s_sleep(1);
        __builtin_amdgcn_fence(__ATOMIC_ACQUIRE, "agent");
        asm volatile("s_waitcnt vmcnt(0)" ::: "memory");
    }
    __syncthreads();
}

struct Frame {
    LAS unsigned char* lds;
    unsigned* ctl;
    int vcu, G;
    unsigned char* ws; float* out;
    const float *x, *w_in, *conv_w, *w_o, *ln1_g, *ln1_b, *rel_bias, *w_router, *router_bias, *eg, *eu, *ed, *sg, *su, *sd, *ln2_g, *ln2_b;
};
__device__ __forceinline__ float wave_sum(float v) {
#pragma unroll
    for (int o = 1; o < 64; o <<= 1) v += __shfl_xor(v, o);
    return v;
}

struct DenseOrder {
    int nM, nN, nwg, G, c, K; const char* Bt;
    __device__ __forceinline__ void init(int M, int N, int K_, int G_, int c_, const void* Bt_) { nM = M / 256; nN = N / 256; nwg = nM * nN; G = G_; c = c_; K = K_; Bt = (const char*)Bt_; }
    __device__ __forceinline__ bool next(int i, pg8::Unit& u) const {
        const long L = (long)i * G + c; if (L >= nwg) return false;
        int wgid = (int)L; { const int q = nwg / 8, r = nwg % 8, xcd = wgid % 8, off = wgid / 8; wgid = (xcd < r ? xcd * (q + 1) : r * (q + 1) + (xcd - r) * q) + off; }
        const int nig = 8 * nN, gid = wgid / nig, fm = gid * 8, gsz = (nM - fm) < 8 ? (nM - fm) : 8;
        u.pm = fm + ((wgid % nig) % gsz); u.pn = (wgid % nig) / gsz; u.aux = 0; return true;
    }
    __device__ __forceinline__ void a_off(const pg8::Unit& u, const int (&R)[2], const int (&C)[2], unsigned (&vo)[2][2]) const {
#pragma unroll
        for (int h = 0; h < 2; ++h)
#pragma unroll
            for (int i = 0; i < 2; ++i) vo[h][i] = (unsigned)((u.pm * 256 + 128 * h + R[i]) * K + C[i]) * 2u;
    }
    __device__ __forceinline__ const char* b_base(const pg8::Unit& u) const { return Bt + (size_t)u.pn * 256 * K * 2; }
};
struct MoeOrder {
    int nunits, G, c, shift, p0, K; const int* panel_e; const int* row_src; const char* W; size_t wbytes;
    __device__ __forceinline__ bool next(int i, pg8::Unit& u) const {
        const long L = (long)i * G + c; if (L >= nunits) return false;
        u.pm = p0 + (int)(L >> shift); u.pn = (int)(L & ((1 << shift) - 1)); u.aux = __builtin_amdgcn_readfirstlane(panel_e[u.pm]); return true;
    }
    __device__ __forceinline__ void a_off(const pg8::Unit& u, const int (&R)[2], const int (&C)[2], unsigned (&vo)[2][2]) const {
#pragma unroll
        for (int h = 0; h < 2; ++h)
#pragma unroll
            for (int i = 0; i < 2; ++i) {
                const int row = u.pm * 256 + 128 * h + R[i];
                vo[h][i] = row_src ? ((unsigned)row_src[row] * (unsigned)(K * 2) + (unsigned)C[i] * 2u) : ((unsigned)(row * K + C[i]) * 2u);
            }
    }
    __device__ __forceinline__ const char* b_base(const pg8::Unit& u) const { return W + (size_t)u.aux * wbytes + (size_t)u.pn * 256 * K * 2; }
};

struct EpiProj {
    static constexpr bool PERM = true;
    bf16_t* QKV; bf16_t* CV;
    __device__ __forceinline__ void operator()(const f32x4 (&acc)[2][2][4][2], const pg8::Unit& u, int wr, int wc, int fr, int fq) const {
        const int row0 = u.pm * 256 + wr * 64 + fr;
#pragma unroll
        for (int bj = 0; bj < 2; ++bj) { const int col = u.pn * 256 + bj * 128 + wc * 32 + 8 * fq;
            bf16_t* base; size_t rstride;
            if (col < 2304) { const int which = col / 768, hc = col % 768, h = hc >> 6, d = hc & 63; base = QKV + ((size_t)which * 32 * NH + h) * (SEQ * 64) + d; rstride = 0; }
            else { base = CV + (col - 2304); rstride = 1; }
#pragma unroll
            for (int ai = 0; ai < 2; ++ai)
#pragma unroll
                for (int m = 0; m < 4; ++m) { const int row = row0 + ai * 128 + m * 16; const int b = row >> 11, t = row & (SEQ - 1);
                    bf16_t* p = rstride ? base + (size_t)row * 768 : base + (size_t)b * NH * (SEQ * 64) + (size_t)t * 64;
                    const f32x4 v0 = acc[ai][bj][m][0], v1 = acc[ai][bj][m][1];
                    constexpr float r = 1.f / (X_SCALE * W13_SCALE);
                    u32x4 w; w.x = cvtpk(v0[0] * r, v0[1] * r); w.y = cvtpk(v0[2] * r, v0[3] * r); w.z = cvtpk(v1[0] * r, v1[1] * r); w.w = cvtpk(v1[2] * r, v1[3] * r);
                    *(u32x4*)p = w; }
        }
    }
};
struct EpiF32 {
    static constexpr bool PERM = false;
    float* C; int ldc;
    __device__ __forceinline__ void operator()(const f32x4 (&acc)[2][2][4][2], const pg8::Unit& u, int wr, int wc, int fr, int fq) const {
        const int row0 = u.pm * 256 + wr * 64 + fr, col0 = u.pn * 256 + wc * 32 + 4 * fq;
#pragma unroll
        for (int ai = 0; ai < 2; ++ai)
#pragma unroll
            for (int m = 0; m < 4; ++m) { float* rowp = C + (size_t)(row0 + ai * 128 + m * 16) * ldc + col0;
#pragma unroll
                for (int bj = 0; bj < 2; ++bj)
#pragma unroll
                    for (int n = 0; n < 2; ++n) *(f32x4*)(rowp + bj * 128 + n * 16) = acc[ai][bj][m][n]; }
    }
};
struct EpiWo {
    static constexpr bool PERM = true;
    bf16_t* Z; const float* X;
    __device__ __forceinline__ void operator()(const f32x4 (&acc)[2][2][4][2], const pg8::Unit& u, int wr, int wc, int fr, int fq) const {
        const int row0 = u.pm * 256 + wr * 64 + fr, col0 = u.pn * 256 + wc * 32 + 8 * fq;
#pragma unroll
        for (int ai = 0; ai < 2; ++ai)
#pragma unroll
            for (int m = 0; m < 4; ++m) { const size_t ro = (size_t)(row0 + ai * 128 + m * 16) * DM + col0;
#pragma unroll
                for (int bj = 0; bj < 2; ++bj) { const f32x4 x0 = *(const f32x4*)(X + ro + bj * 128), x1 = *(const f32x4*)(X + ro + bj * 128 + 4);
                    const f32x4 v0 = x0 * ALPHA + acc[ai][bj][m][0], v1 = x1 * ALPHA + acc[ai][bj][m][1];
                    u32x4 w; w.x = cvtpk(v0[0], v0[1]); w.y = cvtpk(v0[2], v0[3]); w.z = cvtpk(v1[0], v1[1]); w.w = cvtpk(v1[2], v1[3]);
                    *(u32x4*)(Z + ro + bj * 128) = w; } }
    }
};
__device__ __forceinline__ float silu_mul(float g, float u) { const float e = __builtin_amdgcn_exp2f(-g * LOG2E); return g * __builtin_amdgcn_rcpf(1.f + e) * u; }
constexpr float H_SCALE = 8.f, WD_SCALE = 8.f;
__device__ __forceinline__ float h8(float g, float u) { constexpr float r = 1.f / (X_SCALE * W13_SCALE); return __builtin_amdgcn_fmed3f(silu_mul(g * r, u * r) * H_SCALE, -448.f, 448.f); }
struct EpiGU {
    static constexpr bool PERM = true;
    unsigned char* H;
    __device__ __forceinline__ void operator()(const f32x4 (&acc)[2][2][4][2], const pg8::Unit& u, int wr, int wc, int fr, int fq) const {
        const int row0 = u.pm * 256 + wr * 64 + fr, col0 = u.pn * 128 + wc * 32 + 8 * fq;
#pragma unroll
        for (int ai = 0; ai < 2; ++ai)
#pragma unroll
            for (int m = 0; m < 4; ++m) { unsigned char* rowp = H + (size_t)(row0 + ai * 128 + m * 16) * EDIM + col0;
                const f32x4 g0 = acc[ai][0][m][0], g1 = acc[ai][0][m][1], u0 = acc[ai][1][m][0], u1 = acc[ai][1][m][1];
                int w0 = 0, w1 = 0;
                w0 = __builtin_amdgcn_cvt_pk_fp8_f32(h8(g0[0], u0[0]), h8(g0[1], u0[1]), w0, false); w0 = __builtin_amdgcn_cvt_pk_fp8_f32(h8(g0[2], u0[2]), h8(g0[3], u0[3]), w0, true);
                w1 = __builtin_amdgcn_cvt_pk_fp8_f32(h8(g1[0], u1[0]), h8(g1[1], u1[1]), w1, false); w1 = __builtin_amdgcn_cvt_pk_fp8_f32(h8(g1[2], u1[2]), h8(g1[3], u1[3]), w1, true);
                u32x2 w; w.x = (unsigned)w0; w.y = (unsigned)w1;
                *(u32x2*)rowp = w; }
    }
};
__device__ __forceinline__ int t5_bucket(int dist) {
    if (dist < 16) return dist;
    int b = 16;
    b += dist >= 22; b += dist >= 30; b += dist >= 40; b += dist >= 54; b += dist >= 73; b += dist >= 99; b += dist >= 134; b += dist >= 182;
    b += dist >= 246; b += dist >= 332; b += dist >= 450; b += dist >= 609; b += dist >= 825; b += dist >= 1117; b += dist >= 1513;
    return b;
}
__device__ __forceinline__ void transpose_item(const float* W, int N, int k0, int n0, bf16_t* WT, int ldk, int out_row0, LAS float* scr, int lane) {
#pragma unroll 8
    for (int i = 0; i < 32; ++i) { const int kk = 2 * i + (lane >> 5); scr[kk * 33 + (lane & 31)] = W[(size_t)(k0 + kk) * N + n0 + (lane & 31)]; }
    LDS_WAIT(); asm volatile("" ::: "memory");
    const int c = lane & 7;
#pragma unroll
    for (int j = 0; j < 4; ++j) { const int n = (lane >> 3) + 8 * j; const LAS float* s = scr + (8 * c) * 33 + n;
        u32x4 o; o.x = cvtpk(s[0 * 33], s[1 * 33]); o.y = cvtpk(s[2 * 33], s[3 * 33]); o.z = cvtpk(s[4 * 33], s[5 * 33]); o.w = cvtpk(s[6 * 33], s[7 * 33]);
        *(u32x4*)(WT + (size_t)(out_row0 + n) * ldk + k0 + 8 * c) = o; }
    LDS_WAIT(); asm volatile("" ::: "memory");
}
__device__ __forceinline__ void transpose_item8(const float* W, int N, int k0, int n0, unsigned char* WT, int ldk, int out_row0, float sc, LAS float* scr, int lane) {
#pragma unroll 8
    for (int i = 0; i < 32; ++i) { const int kk = 2 * i + (lane >> 5); scr[kk * 33 + (lane & 31)] = W[(size_t)(k0 + kk) * N + n0 + (lane & 31)]; }
    LDS_WAIT(); asm volatile("" ::: "memory");
    const int c = lane & 3;
#pragma unroll
    for (int j = 0; j < 2; ++j) { const int n = (lane >> 2) + 16 * j; const LAS float* s = scr + (16 * c) * 33 + n;
        int w0 = 0, w1 = 0, w2 = 0, w3 = 0;
        w0 = __builtin_amdgcn_cvt_pk_fp8_f32(s[0 * 33] * sc, s[1 * 33] * sc, w0, false); w0 = __builtin_amdgcn_cvt_pk_fp8_f32(s[2 * 33] * sc, s[3 * 33] * sc, w0, true);
        w1 = __builtin_amdgcn_cvt_pk_fp8_f32(s[4 * 33] * sc, s[5 * 33] * sc, w1, false); w1 = __builtin_amdgcn_cvt_pk_fp8_f32(s[6 * 33] * sc, s[7 * 33] * sc, w1, true);
        w2 = __builtin_amdgcn_cvt_pk_fp8_f32(s[8 * 33] * sc, s[9 * 33] * sc, w2, false); w2 = __builtin_amdgcn_cvt_pk_fp8_f32(s[10 * 33] * sc, s[11 * 33] * sc, w2, true);
        w3 = __builtin_amdgcn_cvt_pk_fp8_f32(s[12 * 33] * sc, s[13 * 33] * sc, w3, false); w3 = __builtin_amdgcn_cvt_pk_fp8_f32(s[14 * 33] * sc, s[15 * 33] * sc, w3, true);
        u32x4 o; o.x = (unsigned)w0; o.y = (unsigned)w1; o.z = (unsigned)w2; o.w = (unsigned)w3;
        *(u32x4*)(WT + (size_t)(out_row0 + n) * ldk + k0 + 16 * c) = o; }
    LDS_WAIT(); asm volatile("" ::: "memory");
}
__device__ __forceinline__ void p0_prologue(Frame& F) {
    const int tid_ = opaque_tid(), lane_ = tid_ & 63, wave_ = __builtin_amdgcn_readfirstlane(tid_ >> 6);
    LAS float* scr = (LAS float*)(F.lds + wave_ * 8448);
    const int gw = F.vcu * NWAVES + wave_, NGW = F.G * NWAVES, lane = lane_;
    bf16_t* win_t = (bf16_t*)(F.ws + WS_WIN); bf16_t* wo_t = (bf16_t*)(F.ws + WS_WO); bf16_t* wr_t = (bf16_t*)(F.ws + WS_WR);
    unsigned char* w13 = F.ws + WS_W13  ; unsigned char* wd = F.ws + WS_WD;
    constexpr int I_IN = 16 * 96, I_O = 16 * 32, I_R = 16 * 8, I_SMALL = I_IN + I_O + I_R;
    for (int it = gw; it < I_SMALL; it += NGW) {
        int r = it;
        if (r < I_IN) { const int kb = r / 96, nb = r % 96; transpose_item8(F.w_in, PROJW, 64 * kb, 32 * nb, (unsigned char*)win_t, DM, 32 * nb, W13_SCALE, scr, lane); continue; } r -= I_IN;
        if (r < I_O) { const int kb = r / 32, nb = r % 32; transpose_item(F.w_o, DM, 64 * kb, 32 * nb, wo_t, DM, 32 * nb, scr, lane); continue; } r -= I_O;
        { const int kb = r / 8, nb = r % 8; transpose_item(F.w_router, NEXP, 64 * kb, 32 * nb, wr_t, DM, 32 * nb, scr, lane); }
    }
    { float* bt = (float*)(F.ws + WS_BIAS);
      for (int i = F.vcu * 512 + tid_; i < 3 * NH * 192; i += F.G * 512) { const int g = i / (NH * 192), r = i % (NH * 192), h = r / 192, e = r % 192, st = e - 32;
        float v = -INFINITY; if (st >= 0 && st <= 128) v = F.rel_bias[t5_bucket(st << (2 * g)) * NH + h] * LOG2E; bt[i] = v; } }
    { const f32x4* xs = (const f32x4*)F.x; u32x4* xd = (u32x4*)(F.ws + WS_XB); const size_t n16 = (size_t)NTOK * DM / 16, stride = (size_t)F.G * 512;
        for (size_t i = (size_t)F.vcu * 512 + tid_; i < n16; i += stride) { u32x4 o; int wv[4];
#pragma unroll
            for (int j = 0; j < 4; ++j) { const f32x4 a = xs[4 * i + j]; int wj = 0;
                wj = __builtin_amdgcn_cvt_pk_fp8_f32(__builtin_amdgcn_fmed3f(a[0] * X_SCALE, -448.f, 448.f), __builtin_amdgcn_fmed3f(a[1] * X_SCALE, -448.f, 448.f), wj, false);
                wj = __builtin_amdgcn_cvt_pk_fp8_f32(__builtin_amdgcn_fmed3f(a[2] * X_SCALE, -448.f, 448.f), __builtin_amdgcn_fmed3f(a[3] * X_SCALE, -448.f, 448.f), wj, true); wv[j] = wj; }
            o.x = (unsigned)wv[0]; o.y = (unsigned)wv[1]; o.z = (unsigned)wv[2]; o.w = (unsigned)wv[3]; xd[i] = o; } }
}

__device__ __forceinline__ float lane_swap_max(float m) { asm volatile("s_nop 7" : "+v"(m)); auto rr = __builtin_amdgcn_permlane32_swap(__float_as_uint(m), __float_as_uint(m), false, false); unsigned r0 = rr[0], r1 = rr[1]; asm volatile("s_nop 7" : "+v"(r0), "+v"(r1)); return fmaxf(__uint_as_float(r0), __uint_as_float(r1)); }
__device__ __forceinline__ float lane_swap_sum(float m) { asm volatile("s_nop 7" : "+v"(m)); auto rr = __builtin_amdgcn_permlane32_swap(__float_as_uint(m), __float_as_uint(m), false, false); unsigned r0 = rr[0], r1 = rr[1]; asm volatile("s_nop 7" : "+v"(r0), "+v"(r1)); return __uint_as_float(r0) + __uint_as_float(r1); }
__device__ __forceinline__ int crow(int r, int hi) { return (r & 3) + 8 * (r >> 2) + 4 * hi; }

template <int GB>
__device__ __forceinline__ void attn_pair(Frame& F, int pair) {
    const int tid_ = opaque_tid(), lane_ = tid_ & 63, wave_ = __builtin_amdgcn_readfirstlane(tid_ >> 6);
    constexpr int DIL = 1 << (2 * GB), NB = 16 / DIL;
    const int tid = tid_, hw = wave_ >> 2, w = wave_ & 3, ht = tid & 255, lane = lane_, r32 = lane & 31, hi = lane >> 5;
    const int u = pair * 2 + hw;
    const int b = u / 192, rem = u % 192, hh = rem >> 4, blk = rem & 15;
    const int r = blk / NB, n = blk % NB;
    LAS unsigned char* base = F.lds + hw * ATT_HALF;
    LAS unsigned char* Kl = base + ATT_K; LAS unsigned char* Vl = base + ATT_V; LAS float* tbl = (LAS float*)(base + ATT_TBL); LAS float* sc = (LAS float*)(base + ATT_SC + w * 256);
    const bf16_t* proj = (const bf16_t*)(F.ws + WS_PROJ);
    bf16_t* A2 = (bf16_t*)(F.ws + WS_XB); float* lse_buf = (float*)(F.ws + WS_LSE);
    const size_t tok0 = (size_t)b * SEQ + r;
    const bf16_t* qh = proj + ((size_t)(0 * 32 + b) * NH + hh) * (SEQ * 64); const bf16_t* kh = proj + ((size_t)(1 * 32 + b) * NH + hh) * (SEQ * 64); const bf16_t* vh = proj + ((size_t)(2 * 32 + b) * NH + hh) * (SEQ * 64);
    if (ht < 192) tbl[ht] = ((const float*)(F.ws + WS_BIAS))[(GB * NH + hh) * 192 + ht];
    {
        const int c = ht & 7, rb = ht >> 3;
        u32x4 kv[8], vv[8];
#pragma unroll
        for (int it = 0; it < 8; ++it) { const int ki = it * 32 + rb, l = 128 * (n - 1) + ki;
            if (l >= 0) { const size_t ro = (size_t)(l * DIL + r) * 64 + c * 8; kv[it] = *(const u32x4*)(kh + ro); vv[it] = *(const u32x4*)(vh + ro); }
            else { kv[it] = (u32x4){0u, 0u, 0u, 0u}; vv[it] = (u32x4){0u, 0u, 0u, 0u}; } }
#pragma unroll
        for (int it = 0; it < 8; ++it) { const int ki = it * 32 + rb;
            *(LAS u32x4*)(Kl + ki * 144 + c * 16) = kv[it];
            const u32x4 v = vv[it]; const int sw = ((ki >> 1) & 1) * 64;
            u32x2 ev, od; ev.x = (v.x & 0xffffu) | (v.y << 16); ev.y = (v.z & 0xffffu) | (v.w << 16); od.x = (v.x >> 16) | (v.y & 0xffff0000u); od.y = (v.z >> 16) | (v.w & 0xffff0000u);
            *(LAS u32x2*)(Vl + ki * 128 + (0 ^ sw) + c * 8) = ev; *(LAS u32x2*)(Vl + ki * 128 + (64 ^ sw) + c * 8) = od; }
    }
    bf16x8 qf[4];
    const int lq = 128 * n + 32 * w + r32;
    { const bf16_t* qs = qh + (size_t)(lq * DIL + r) * 64 + hi * 8;
#pragma unroll
        for (int ds = 0; ds < 4; ++ds) qf[ds] = *(const bf16x8*)(qs + ds * 16); }
    __syncthreads();
    f32x16 S[5];
    constexpr float SC = 0.125f * LOG2E;
#pragma unroll
    for (int jj = 0; jj < 5; ++jj) {
        const int j = w + jj; const bool act = (n > 0) || (j >= 4);
        if (act) {
            f32x16 a;
#pragma unroll
            for (int i = 0; i < 16; ++i) a[i] = 0.f;
            asm volatile("" : "+v"(a));
            const LAS unsigned char* kp = Kl + (32 * j + r32) * 144 + hi * 16;
#pragma unroll
            for (int ds = 0; ds < 4; ++ds) { const bf16x8 kf = *(const LAS bf16x8*)(kp + ds * 32); a = __builtin_amdgcn_mfma_f32_32x32x16_bf16(kf, qf[ds], a, 0, 0, 0); }
            const int ib = 160 - 32 * jj + r32 - 4 * hi;
#pragma unroll
            for (int i = 0; i < 16; ++i) a[i] = a[i] * SC + *(volatile LAS float*)(tbl + (ib - (i & 3) - 8 * (i >> 2)));
            S[jj] = a;
        } else {
#pragma unroll
            for (int i = 0; i < 16; ++i) S[jj][i] = -INFINITY;
        }
    }
    float m = -INFINITY;
#pragma unroll
    for (int jj = 0; jj < 5; ++jj)
#pragma unroll
        for (int i = 0; i < 16; ++i) m = fmaxf(m, S[jj][i]);
    m = lane_swap_max(m);
    float lsum = 0.f;
#pragma unroll
    for (int jj = 0; jj < 5; ++jj)
#pragma unroll
        for (int i = 0; i < 16; ++i) { const float p = __builtin_amdgcn_exp2f(S[jj][i] - m); S[jj][i] = p; lsum += p; }
    lsum = lane_swap_sum(lsum);
    f32x16 o[2];
#pragma unroll
    for (int i = 0; i < 16; ++i) { o[0][i] = 0.f; o[1][i] = 0.f; }
    asm volatile("" : "+v"(o[0]), "+v"(o[1]));
    { const int q4 = (lane & 15) >> 2, p4 = lane & 3, cb = (lane >> 4) & 1, swz = ((q4 >> 1) & 1) * 64;
        const LAS unsigned char* vb = Vl + (4 * hi + q4) * 128 + cb * 32 + p4 * 8;
#pragma unroll
        for (int jj = 0; jj < 5; ++jj) {
            const int j = w + jj; const bool act = (n > 0) || (j >= 4);
            if (act) {
#pragma unroll
                for (int s = 0; s < 2; ++s) {
                    u32x4 pw; pw.x = cvtpk(S[jj][8 * s + 0], S[jj][8 * s + 1]); pw.y = cvtpk(S[jj][8 * s + 2], S[jj][8 * s + 3]); pw.z = cvtpk(S[jj][8 * s + 4], S[jj][8 * s + 5]); pw.w = cvtpk(S[jj][8 * s + 6], S[jj][8 * s + 7]);
                    const bf16x8 pa = __builtin_bit_cast(bf16x8, pw);
#pragma unroll
                    for (int dh = 0; dh < 2; ++dh) {
                        const LAS unsigned char* vp = vb + (32 * j + 16 * s) * 128 + ((dh * 64) ^ swz);
                        const s16x4 lo = __builtin_bit_cast(s16x4, __builtin_amdgcn_ds_read_tr16_b64_v4i16((LAS v4i16_t*)vp));
                        const s16x4 hi4 = __builtin_bit_cast(s16x4, __builtin_amdgcn_ds_read_tr16_b64_v4i16((LAS v4i16_t*)(vp + 8 * 128)));
                        const bf16x8 vf = (bf16x8){lo[0], lo[1], lo[2], lo[3], hi4[0], hi4[1], hi4[2], hi4[3]};
                        o[dh] = __builtin_amdgcn_mfma_f32_32x32x16_bf16(pa, vf, o[dh], 0, 0, 0);
                    }
                }
            }
        }
    }
    {
        const size_t tq = tok0 + (size_t)lq * DIL;
        const float lse_new = m + __builtin_amdgcn_logf(lsum);
        float a = 0.f, bco = __builtin_amdgcn_rcpf(lsum), lse_out = lse_new;
        if (GB > 0) {
            const float lp = lse_buf[tq * NH + hh];
            const float M = fmaxf(lp, lse_new), wp = __builtin_amdgcn_exp2f(lp - M), wn = __builtin_amdgcn_exp2f(lse_new - M), den = wp + wn, rd = __builtin_amdgcn_rcpf(den);
            a = wp * rd; bco = wn * rd * __builtin_amdgcn_rcpf(lsum); lse_out = M + __builtin_amdgcn_logf(den);
        }
        if (hi == 0) { sc[r32] = a; sc[32 + r32] = bco; if (GB < 2) ST_WT(lse_buf + tq * NH + hh, lse_out); }
        LDS_WAIT();
    }
    unsigned pvv[16];
    if (GB > 0) {
#pragma unroll
        for (int i = 0; i < 16; ++i) { const size_t tq = tok0 + (size_t)(128 * n + 32 * w + crow(i, hi)) * DIL; pvv[i] = *((const unsigned*)(A2 + tq * DM + hh * 64) + r32); }
        asm volatile("s_waitcnt vmcnt(0)" ::: "memory");
    }
#pragma unroll
    for (int i = 0; i < 16; ++i) {
        const int q = crow(i, hi); const float a = sc[q], bco = sc[32 + q];
        const size_t tq = tok0 + (size_t)(128 * n + 32 * w + q) * DIL;
        unsigned* dst = (unsigned*)(A2 + tq * DM + hh * 64) + r32;
        float v0 = o[0][i] * bco, v1 = o[1][i] * bco;
        if (GB > 0) { v0 += a * bflo(pvv[i]); v1 += a * bfhi(pvv[i]); }
        *dst = cvtpk(v0, v1);
    }
    __syncthreads();
}
template <int GB>
__device__ __forceinline__ void attn_branch(Frame& F) { for (int pair = F.vcu; pair < 3072; pair += F.G) attn_pair<GB>(F, pair); }

__device__ __forceinline__ void conv_phase(Frame& F) {
    const int tid_ = opaque_tid(), lane_ = tid_ & 63, wave_ = __builtin_amdgcn_readfirstlane(tid_ >> 6);
    const bf16_t* cvin = (const bf16_t*)(F.ws + WS_CONVIN); bf16_t* A2 = (bf16_t*)(F.ws + WS_XB);
    const int gw = F.vcu * NWAVES + wave_, NGW = F.G * NWAVES, c0 = lane_ * 4;
    float w0[4], w1[4], w2[4];
#pragma unroll
    for (int j = 0; j < 4; ++j) { w0[j] = F.conv_w[c0 + j]; w1[j] = F.conv_w[256 + c0 + j]; w2[j] = F.conv_w[512 + c0 + j]; }
    for (int t = gw; t < NTOK; t += NGW) {
        const int ts = t & (SEQ - 1);
        float y[4] = {0.f, 0.f, 0.f, 0.f};
#pragma unroll
        for (int k = 0; k < 3; ++k) {
            if (ts - 2 + k >= 0) { const bf16_t* row = cvin + (size_t)(t - 2 + k) * 768;
                const u32x2 cx = *(const u32x2*)(row + c0), cc = *(const u32x2*)(row + 512 + c0);
                const float uu[4] = {bflo(cx.x) * bflo(cc.x), bfhi(cx.x) * bfhi(cc.x), bflo(cx.y) * bflo(cc.y), bfhi(cx.y) * bfhi(cc.y)};
#pragma unroll
                for (int j = 0; j < 4; ++j) y[j] += uu[j] * (k == 0 ? w0[j] : k == 1 ? w1[j] : w2[j]); }
        }
        const u32x2 cb = *(const u32x2*)(cvin + (size_t)t * 768 + 256 + c0);
        u32x2 ov; ov.x = cvtpk(bflo(cb.x) * y[0], bfhi(cb.x) * y[1]); ov.y = cvtpk(bflo(cb.y) * y[2], bfhi(cb.y) * y[3]);
        *(u32x2*)(A2 + (size_t)t * DM + 768 + c0) = ov;
    }
}

__device__ __forceinline__ void ln1_phase(Frame& F) {
    const int tid_ = opaque_tid(), lane_ = tid_ & 63, wave_ = __builtin_amdgcn_readfirstlane(tid_ >> 6);
    const bf16_t* z = (const bf16_t*)F.out; bf16_t* x1 = (bf16_t*)(F.ws + WS_XB);
    const int gw = F.vcu * NWAVES + wave_, NGW = F.G * NWAVES;
    f32x4 g[4], bb[4];
#pragma unroll
    for (int j = 0; j < 4; ++j) { g[j] = *(const f32x4*)(F.ln1_g + lane_ * 16 + 4 * j); bb[j] = *(const f32x4*)(F.ln1_b + lane_ * 16 + 4 * j); }
    for (int mrow = gw; mrow < NTOK; mrow += NGW) {
        const u32x4* zr = (const u32x4*)(z + (size_t)mrow * DM) + 2 * lane_; const u32x4 a = zr[0], b = zr[1];
        float v[16] = {bflo(a.x), bfhi(a.x), bflo(a.y), bfhi(a.y), bflo(a.z), bfhi(a.z), bflo(a.w), bfhi(a.w), bflo(b.x), bfhi(b.x), bflo(b.y), bfhi(b.y), bflo(b.z), bfhi(b.z), bflo(b.w), bfhi(b.w)};
        float s = 0.f;
#pragma unroll
        for (int i = 0; i < 16; ++i) s += v[i];
        const float mean = wave_sum(s) * (1.f / DM); float s2 = 0.f;
#pragma unroll
        for (int i = 0; i < 16; ++i) { v[i] -= mean; s2 += v[i] * v[i]; }
        const float rstd = 1.f / sqrtf(wave_sum(s2) * (1.f / DM) + LN_EPS);
        u32x4 o0, o1;
        { const f32x4 y0 = (f32x4){v[0], v[1], v[2], v[3]} * rstd * g[0] + bb[0], y1 = (f32x4){v[4], v[5], v[6], v[7]} * rstd * g[1] + bb[1];
          const f32x4 y2 = (f32x4){v[8], v[9], v[10], v[11]} * rstd * g[2] + bb[2], y3 = (f32x4){v[12], v[13], v[14], v[15]} * rstd * g[3] + bb[3];
          o0.x = cvtpk(y0.x, y0.y); o0.y = cvtpk(y0.z, y0.w); o0.z = cvtpk(y1.x, y1.y); o0.w = cvtpk(y1.z, y1.w);
          o1.x = cvtpk(y2.x, y2.y); o1.y = cvtpk(y2.z, y2.w); o1.z = cvtpk(y3.x, y3.y); o1.w = cvtpk(y3.z, y3.w); }
        u32x4* xo = (u32x4*)(x1 + (size_t)mrow * DM) + 2 * lane_; xo[0] = o0; xo[1] = o1;
        { u32x4 q;
          const float r = rstd * X_SCALE; const f32x4 gb0 = bb[0] * X_SCALE, gb1 = bb[1] * X_SCALE, gb2 = bb[2] * X_SCALE, gb3 = bb[3] * X_SCALE;
          const f32x4 y0 = (f32x4){v[0], v[1], v[2], v[3]} * r * g[0] + gb0, y1 = (f32x4){v[4], v[5], v[6], v[7]} * r * g[1] + gb1;
          const f32x4 y2 = (f32x4){v[8], v[9], v[10], v[11]} * r * g[2] + gb2, y3 = (f32x4){v[12], v[13], v[14], v[15]} * r * g[3] + gb3;
          int w0 = 0, w1 = 0, w2 = 0, w3 = 0;
          w0 = __builtin_amdgcn_cvt_pk_fp8_f32(y0.x, y0.y, w0, false); w0 = __builtin_amdgcn_cvt_pk_fp8_f32(y0.z, y0.w, w0, true);
          w1 = __builtin_amdgcn_cvt_pk_fp8_f32(y1.x, y1.y, w1, false); w1 = __builtin_amdgcn_cvt_pk_fp8_f32(y1.z, y1.w, w1, true);
          w2 = __builtin_amdgcn_cvt_pk_fp8_f32(y2.x, y2.y, w2, false); w2 = __builtin_amdgcn_cvt_pk_fp8_f32(y2.z, y2.w, w2, true);
          w3 = __builtin_amdgcn_cvt_pk_fp8_f32(y3.x, y3.y, w3, false); w3 = __builtin_amdgcn_cvt_pk_fp8_f32(y3.z, y3.w, w3, true);
          q.x = (unsigned)w0; q.y = (unsigned)w1; q.z = (unsigned)w2; q.w = (unsigned)w3;
          *((u32x4*)(F.ws + WS_X8 + (size_t)mrow * DM) + lane_) = q; }
    }
}

template <int CTRL> __device__ __forceinline__ float dpp_f(float x) { return __builtin_bit_cast(float, __builtin_amdgcn_update_dpp(0, __builtin_bit_cast(int, x), CTRL, 0xf, 0xf, true)); }
__device__ __forceinline__ float wave_max_uniform(float x) {
    x = fmaxf(x, dpp_f<0xB1>(x)); x = fmaxf(x, dpp_f<0x4E>(x)); x = fmaxf(x, dpp_f<0x141>(x)); x = fmaxf(x, dpp_f<0x140>(x));
    const float r0 = __builtin_bit_cast(float, __builtin_amdgcn_readlane(__builtin_bit_cast(int, x), 0)), r1 = __builtin_bit_cast(float, __builtin_amdgcn_readlane(__builtin_bit_cast(int, x), 16));
    const float r2 = __builtin_bit_cast(float, __builtin_amdgcn_readlane(__builtin_bit_cast(int, x), 32)), r3 = __builtin_bit_cast(float, __builtin_amdgcn_readlane(__builtin_bit_cast(int, x), 48));
    return fmaxf(fmaxf(r0, r1), fmaxf(r2, r3));
}
constexpr int CV_ITEMS_E = 384, CV_ITEMS = 257 * CV_ITEMS_E;
struct CvItem { const float* src; unsigned char* dst; int N, ldk; float sc; bool valid; };
__device__ __forceinline__ CvItem cv_decode(const Frame& F, int it, int lane) {
    CvItem c; c.valid = it < CV_ITEMS; if (!c.valid) it = 0;
    const int e = it / CV_ITEMS_E; int r = it % CV_ITEMS_E;
    const float* W; int N, k0, n0, orow; unsigned char* WT;
    if (r < 256) { const bool up = r >= 128; r &= 127; const int kb = r >> 3, nb = r & 7; n0 = 32 * nb; k0 = 64 * kb; N = EDIM;
        W = e < 256 ? (up ? F.eu : F.eg) + (size_t)e * DM * EDIM : (up ? F.su : F.sg); orow = (n0 >> 7) * 256 + (up ? 128 : 0) + (n0 & 127);
        WT = F.ws + WS_W13 + (size_t)e * 512 * DM; c.ldk = DM; c.sc = W13_SCALE; }
    else { r -= 256; const int kb = r >> 5, nb = r & 31; n0 = 32 * nb; k0 = 64 * kb; N = DM;
        W = e < 256 ? F.ed + (size_t)e * EDIM * DM : F.sd; orow = n0;
        WT = F.ws + WS_WD + (size_t)e * DM * EDIM; c.ldk = EDIM; c.sc = WD_SCALE; }
    c.N = N; c.src = W + (size_t)(k0 + (lane >> 5)) * N + n0 + (lane & 31); c.dst = WT + (size_t)orow * c.ldk + k0;
    return c;
}
__device__ __forceinline__ void cv_load(const CvItem& c, float (&r)[32]) {
    if (c.valid) {
#pragma unroll
        for (int i = 0; i < 32; ++i) { const float* p = c.src + (size_t)(2 * i) * c.N; asm volatile("global_load_dword %0, %1, off" : "=v"(r[i]) : "v"(p) : "memory"); }
    }
}
__device__ __forceinline__ void cv_finish(const CvItem& c, const float (&r)[32], LAS float* scr, int lane) {
    if (c.valid) {
#pragma unroll
        for (int i = 0; i < 32; ++i) scr[(2 * i + (lane >> 5)) * 33 + (lane & 31)] = r[i];
        LDS_WAIT(); asm volatile("" ::: "memory");
        const int cc = lane & 3; const float sc = c.sc;
#pragma unroll
        for (int j = 0; j < 2; ++j) { const int n = (lane >> 2) + 16 * j; const volatile LAS float* s = scr + (16 * cc) * 33 + n;
            int w0 = 0, w1 = 0, w2 = 0, w3 = 0;
            w0 = __builtin_amdgcn_cvt_pk_fp8_f32(s[0 * 33] * sc, s[1 * 33] * sc, w0, false); w0 = __builtin_amdgcn_cvt_pk_fp8_f32(s[2 * 33] * sc, s[3 * 33] * sc, w0, true);
            w1 = __builtin_amdgcn_cvt_pk_fp8_f32(s[4 * 33] * sc, s[5 * 33] * sc, w1, false); w1 = __builtin_amdgcn_cvt_pk_fp8_f32(s[6 * 33] * sc, s[7 * 33] * sc, w1, true);
            w2 = __builtin_amdgcn_cvt_pk_fp8_f32(s[8 * 33] * sc, s[9 * 33] * sc, w2, false); w2 = __builtin_amdgcn_cvt_pk_fp8_f32(s[10 * 33] * sc, s[11 * 33] * sc, w2, true);
            w3 = __builtin_amdgcn_cvt_pk_fp8_f32(s[12 * 33] * sc, s[13 * 33] * sc, w3, false); w3 = __builtin_amdgcn_cvt_pk_fp8_f32(s[14 * 33] * sc, s[15 * 33] * sc, w3, true);
            u32x4 o; o.x = (unsigned)w0; o.y = (unsigned)w1; o.z = (unsigned)w2; o.w = (unsigned)w3;
            *(u32x4*)(c.dst + (size_t)n * c.ldk + 16 * cc) = o; }
        LDS_WAIT(); asm volatile("" ::: "memory");
    }
}
__device__ __forceinline__ void route_phase(Frame& F) {
    const int tid_ = opaque_tid(), lane_ = tid_ & 63, wave_ = __builtin_amdgcn_readfirstlane(tid_ >> 6);
    const float* logits = (const float*)(F.ws + WS_LOGIT); int* top_e = (int*)(F.ws + WS_TOPE); float* top_w = (float*)(F.ws + WS_TOPW);
    LAS int* lhist = (LAS int*)(F.lds + 8 * 8448);
    LAS float* scr = (LAS float*)(F.lds + wave_ * 8448);
    const int lane = lane_;
    const int cv_stride = F.G * NWAVES; int cv_next = F.vcu * NWAVES + wave_;
    float rb[4];
#pragma unroll
    for (int j = 0; j < 4; ++j) rb[j] = F.router_bias[lane * 4 + j];
    for (int chunk = F.vcu; chunk < NTOK / 256; chunk += F.G) {
        if (tid_ < 256) lhist[tid_] = 0;
        __syncthreads();
        const f32x4* lgp = (const f32x4*)(logits + (size_t)(chunk * 256 + wave_ * 32) * NEXP) + lane;
        f32x4 lg1 = lgp[0], lg2 = lgp[64];
#pragma unroll 1
        for (int tt = 0; tt < 32; ++tt) {
            const int t = chunk * 256 + wave_ * 32 + tt;
            asm volatile("s_waitcnt vmcnt(0)" ::: "memory");
            f32x4 lg = lg1; lg1 = lg2; if (tt + 2 < 32) lg2 = lgp[(tt + 2) * 64];
            asm volatile("" : "+v"(lg), "+v"(lg1));
            __builtin_amdgcn_sched_barrier(0);
            const CvItem ca = cv_decode(F, cv_next, lane), cb = cv_decode(F, cv_next + cv_stride, lane); cv_next += 2 * cv_stride;
            float ra[32], rbuf[32];
            cv_load(ca, ra); cv_load(cb, rbuf);
            __builtin_amdgcn_sched_barrier(0);
            float s[4], v[4];
#pragma unroll
            for (int j = 0; j < 4; ++j) { s[j] = __builtin_amdgcn_rcpf(1.f + __builtin_amdgcn_exp2f(-lg[j] * LOG2E)); v[j] = s[j] + rb[j]; }
            float t1, t2;
            { const float a1 = fmaxf(v[0], v[1]), a2 = fminf(v[0], v[1]), b1 = fmaxf(v[2], v[3]), b2 = fminf(v[2], v[3]); t1 = fmaxf(a1, b1); t2 = fmaxf(fminf(a1, b1), fmaxf(a2, b2)); }
            { const float o1 = dpp_f<0xB1>(t1), o2 = dpp_f<0xB1>(t2); const float n1 = fmaxf(t1, o1), n2 = fmaxf(fminf(t1, o1), fmaxf(t2, o2)); t1 = n1; t2 = n2; }
            { const float o1 = dpp_f<0x4E>(t1), o2 = dpp_f<0x4E>(t2); const float n1 = fmaxf(t1, o1), n2 = fmaxf(fminf(t1, o1), fmaxf(t2, o2)); t1 = n1; t2 = n2; }
            { const float o1 = dpp_f<0x141>(t1), o2 = dpp_f<0x141>(t2); const float n1 = fmaxf(t1, o1), n2 = fmaxf(fminf(t1, o1), fmaxf(t2, o2)); t1 = n1; t2 = n2; }
            const float gs = t1 + t2; const int g = lane >> 3; int rank = 0;
#pragma unroll
            for (int gg = 0; gg < 8; ++gg) { const float og = __builtin_bit_cast(float, __builtin_amdgcn_readlane(__builtin_bit_cast(int, gs), 8 * gg)); rank += (og > gs || (og == gs && gg < g)) ? 1 : 0; }
            if (rank >= 4) { v[0] = -INFINITY; v[1] = -INFINITY; v[2] = -INFINITY; v[3] = -INFINITY; }
            int my_e = 0; float my_s = 0.f, ssum = 0.f;
#pragma unroll
            for (int k = 0; k < 8; ++k) {
                const float mx = wave_max_uniform(fmaxf(fmaxf(v[0], v[1]), fmaxf(v[2], v[3])));
                int best = 1 << 20;
#pragma unroll
                for (int j = 0; j < 4; ++j) { const unsigned long long bal = __ballot(v[j] == mx); const int cand = bal ? (4 * (int)__builtin_ctzll(bal) + j) : (1 << 20); best = cand < best ? cand : best; }
                const int wj = best & 3, wl = best >> 2;
                const float sel = wj == 0 ? s[0] : wj == 1 ? s[1] : wj == 2 ? s[2] : s[3];
                const float sw = __builtin_bit_cast(float, __builtin_amdgcn_readlane(__builtin_bit_cast(int, sel), wl));
                const bool mine = lane == wl;
#pragma unroll
                for (int j = 0; j < 4; ++j) v[j] = (mine && wj == j) ? -INFINITY : v[j];
                my_e = lane == k ? best : my_e; my_s = lane == k ? sw : my_s; ssum += sw;
            }
            if (lane < 8) { top_e[(size_t)t * 8 + lane] = my_e; top_w[(size_t)t * 8 + lane] = my_s / ssum * 2.5f; __hip_atomic_fetch_add(&lhist[my_e], 1, __ATOMIC_RELAXED, __HIP_MEMORY_SCOPE_WORKGROUP); }
            asm volatile("s_waitcnt vmcnt(0)" ::: "memory");
            cv_finish(ca, ra, scr, lane); cv_finish(cb, rbuf, scr, lane);
        }
        __syncthreads();
        if (tid_ < 256) { const int c = lhist[tid_]; if (c) atomicAdd(F.ctl + CW_CNT + tid_, (unsigned)c); }
        __syncthreads();
    }
    for (; cv_next < CV_ITEMS; cv_next += cv_stride) { float r0[32]; const CvItem c = cv_decode(F, cv_next, lane); cv_load(c, r0); asm volatile("s_waitcnt vmcnt(0)" ::: "memory"); cv_finish(c, r0, scr, lane); }
}

__device__ __forceinline__ char* slot_addr(unsigned char* ws, float* out, int s, int t) {
    if (s < 4) return (char*)out + (size_t)t * 4096 + (size_t)s * 1024;
    if (s < 8) return (char*)ws + WS_W13 + (size_t)(s - 4) * 64 * MiB + (size_t)t * 1024;
    return (char*)ws + WS_LOGIT + (size_t)t * 1024;
}

__device__ __forceinline__ void lists_phase(Frame& F) {
    const int tid_ = opaque_tid();
    LAS int* seg_start = (LAS int*)F.lds;
    LAS int* seg_cnt = seg_start + 264;
    LAS int* lhist = seg_cnt + 264;
    LAS int* gbase = lhist + 256;
    const int* top_e = (const int*)(F.ws + WS_TOPE); const float* top_w = (const float*)(F.ws + WS_TOPW);
    int* row_src = (int*)(F.ws + WS_ROWSRC); float* row_w = (float*)(F.ws + WS_ROWW); unsigned long long* row_ptr = (unsigned long long*)(F.ws + WS_ROWPTR); int* panel_e = (int*)(F.ws + WS_PANEL);
    for (int v = tid_; v < NSEG; v += 512) seg_cnt[v] = v == 256 ? NTOK : (int)__hip_atomic_load(F.ctl + CW_CNT + v, __ATOMIC_RELAXED, __HIP_MEMORY_SCOPE_AGENT);
    __syncthreads();
    if (tid_ == 0) { int acc = 0; for (int v = 0; v < NSEG; ++v) { seg_start[v] = acc; acc += (*(volatile LAS int*)(seg_cnt + v) + 255) & ~255; } seg_start[NSEG] = acc;
        if (blockIdx.x == 0) ST_WT(F.ctl + CW_PT, (unsigned)(acc >> 8)); }
    __syncthreads();
    for (int v = F.vcu; v < NSEG; v += F.G) {
        const int s0 = seg_start[v], cnt = seg_cnt[v], s1 = seg_start[v + 1];
        for (int rr = s0 + cnt + tid_; rr < s1; rr += 512) { ST_WT(row_src + rr, 0); ST_WT(row_w + rr, 0.f); ST_WT(row_ptr + rr, (unsigned long long)(F.ws + WS_DUMP + (size_t)(rr & 1023) * 2048)); }
        for (int p = (s0 >> 8) + tid_; p < (s1 >> 8); p += 512) ST_WT(panel_e + p, v);
    }
    for (int i = F.vcu * 512 + tid_; i < NTOK; i += F.G * 512) { const int rr = seg_start[256] + i;
        ST_WT(row_src + rr, i); ST_WT(row_w + rr, SLOT_SCALE); ST_WT(row_ptr + rr, (unsigned long long)slot_addr(F.ws, F.out, 8, i)); }
    for (int chunk = F.vcu; chunk < NTOK / 256; chunk += F.G) {
        if (tid_ < 256) lhist[tid_] = 0;
        __syncthreads();
        int e4[4], lr[4];
#pragma unroll
        for (int k = 0; k < 4; ++k) { const int a = chunk * 2048 + tid_ * 4 + k; e4[k] = top_e[a]; lr[k] = __hip_atomic_fetch_add(&lhist[e4[k]], 1, __ATOMIC_RELAXED, __HIP_MEMORY_SCOPE_WORKGROUP); }
        __syncthreads();
        if (tid_ < 256) { const int c = lhist[tid_]; gbase[tid_] = c ? (int)atomicAdd(F.ctl + CW_CUR + tid_, (unsigned)c) : 0; }
        __syncthreads();
#pragma unroll
        for (int k = 0; k < 4; ++k) { const int a = chunk * 2048 + tid_ * 4 + k, tok = a >> 3, slot = a & 7;
            const int rr = seg_start[e4[k]] + gbase[e4[k]] + lr[k];
            ST_WT(row_src + rr, tok); ST_WT(row_w + rr, top_w[a] * SLOT_SCALE); ST_WT(row_ptr + rr, (unsigned long long)slot_addr(F.ws, F.out, slot, tok)); }
        __syncthreads();
    }
}

constexpr int DN_RING = 0, DN_NSLOT = 6, DN_SLOT = 16384, DN_STG = DN_NSLOT * DN_SLOT, DN_STG_ROW = 144, DN_STG_WAVE = 32 * DN_STG_ROW, DN_TOUCH = DN_STG + 8 * DN_STG_WAVE;
static_assert(DN_TOUCH + 8 * 256 <= MISC_OFF, "down-phase LDS map");
__device__ __forceinline__ int dn_colperm(int s) { return 16 * ((s >> 2) & 1) + (s & 3) + 4 * (s >> 3); }
#define DN_LDSRD(dst, addr, off) asm volatile("ds_read_b128 %0, %1 offset:%2" : "=v"(dst) : "v"(addr), "n"(off))
#define DN_DRAIN(ACC, t, dst) do { _Pragma("unroll") for (int m_ = 2 * (t); m_ < 2 * (t) + 2; ++m_) { const int j_ = m_ >> 1, h_ = m_ & 1; const float x0_ = ACC[4 * j_ + 2 * h_] * rw, x1_ = ACC[4 * j_ + 2 * h_ + 1] * rw; \
            ow[j_] = h_ ? __builtin_amdgcn_cvt_pk_fp8_f32(x0_, x1_, ow[j_], true) : __builtin_amdgcn_cvt_pk_fp8_f32(x0_, x1_, ow[j_], false); asm volatile("" : "+v"(ow[j_])); } \
        if ((t) == 3) { u32x4 o_; o_.x = (unsigned)ow[0]; o_.y = (unsigned)ow[1]; o_.z = (unsigned)ow[2]; o_.w = (unsigned)ow[3]; *(LAS u32x4*)(dst) = o_; } } while (0)
#define DN_MFMA(ACC, t, FIRSTSTEP) do { const i32x8 wa_ = __builtin_shufflevector(__builtin_bit_cast(i32x4, W[2 * (t)]), __builtin_bit_cast(i32x4, W[2 * (t) + 1]), 0, 1, 2, 3, 4, 5, 6, 7); \
        if (FIRSTSTEP) { f32x16 z_; _Pragma("unroll") for (int q_ = 0; q_ < 16; ++q_) z_[q_] = 0.f; \
            ACC = __builtin_amdgcn_mfma_scale_f32_32x32x64_f8f6f4(wa_, __builtin_bit_cast(i32x8, hq[t]), z_, 0, 0, 0, 0x7F7F7F7F, 0, 0x7F7F7F7F); wkeep = wa_; } \
        else ACC = __builtin_amdgcn_mfma_scale_f32_32x32x64_f8f6f4(wa_, __builtin_bit_cast(i32x8, hq[t]), ACC, 0, 0, 0, 0x7F7F7F7F, 0, 0x7F7F7F7F); } while (0)
template <bool FIRST, int PAR, bool FLUSH>
__device__ __forceinline__ void dn_chunk(const char* nsrc, f32x16& accA, f32x16& accB, u32x4 (&W)[8], const u32x8 (&hq)[4], LAS unsigned char* lds, unsigned (&a)[8], int& rs,
                                         const float rw, LAS unsigned char* stg_t0, const unsigned stg_ra, GAS char* (&gq)[4], const bool (&ok)[4], const unsigned (&dsrc)[2], const int w) {
    {
        int ow[4] = {0, 0, 0, 0}; i32x8 wkeep;
#pragma unroll
        for (int t = 0; t < 4; ++t) {
            asm volatile("s_waitcnt lgkmcnt(6)" : "+v"(W[2 * t]), "+v"(W[2 * t + 1]));
            DN_MFMA(accA, t, t == 0);
            DN_LDSRD(W[2 * t], a[2 * t], 8192); DN_LDSRD(W[2 * t + 1], a[2 * t + 1], 8192);
            if (t == 0) asm volatile("" : "+v"(accA) : "v"(wkeep));
            if (!FIRST) DN_DRAIN(accB, t, stg_t0 + 64 * (PAR ^ 1) + 32);
            __builtin_amdgcn_sched_barrier(0);
        }
    }
    {
        asm volatile("s_waitcnt vmcnt(8) lgkmcnt(0)" : "+v"(W[0]), "+v"(W[1]), "+v"(W[2]), "+v"(W[3]), "+v"(W[4]), "+v"(W[5]), "+v"(W[6]), "+v"(W[7]) :: "memory");
        __builtin_amdgcn_s_barrier(); asm volatile("" ::: "memory");
        LAS unsigned char* const dd = lds + DN_RING + rs * DN_SLOT + 2 * w * 1024;
        const unsigned dl = (unsigned)(rs == DN_NSLOT - 1 ? -(DN_NSLOT - 1) * DN_SLOT : DN_SLOT); rs = rs == DN_NSLOT - 1 ? 0 : rs + 1;
#pragma unroll
        for (int j = 0; j < 8; ++j) a[j] += dl;
        __builtin_amdgcn_sched_barrier(0);
        int ow[4] = {0, 0, 0, 0}; i32x8 wkeep;
        u32x4 fv0 = {0u, 0u, 0u, 0u}, fv1 = {0u, 0u, 0u, 0u}, fv2 = {0u, 0u, 0u, 0u}, fv3 = {0u, 0u, 0u, 0u};
#pragma unroll
        for (int t = 0; t < 4; ++t) {
            DN_MFMA(accB, t, t == 0);
            DN_LDSRD(W[2 * t], a[2 * t], 0); DN_LDSRD(W[2 * t + 1], a[2 * t + 1], 0);
            if (t == 0) asm volatile("" : "+v"(accB) : "v"(wkeep));
            if (t < 2) __builtin_amdgcn_global_load_lds((const unsigned*)(nsrc + dsrc[t]), (LAS unsigned*)(dd + t * 1024), 16, 0, 0);
            if (FLUSH && t == 0) { DN_LDSRD(fv0, stg_ra, 0); DN_LDSRD(fv1, stg_ra, 8 * DN_STG_ROW); DN_LDSRD(fv2, stg_ra, 16 * DN_STG_ROW); DN_LDSRD(fv3, stg_ra, 24 * DN_STG_ROW); }
            DN_DRAIN(accA, t, stg_t0 + 64 * PAR);
            if (FLUSH && t == 2) { asm volatile("s_waitcnt lgkmcnt(4)" : "+v"(fv0), "+v"(fv1)); if (ok[0]) *(GAS u32x4*)gq[0] = fv0; if (ok[1]) *(GAS u32x4*)gq[1] = fv1; }
            if (FLUSH && t == 3) { asm volatile("s_waitcnt lgkmcnt(4)" : "+v"(fv2), "+v"(fv3)); if (ok[2]) *(GAS u32x4*)gq[2] = fv2; if (ok[3]) *(GAS u32x4*)gq[3] = fv3;
                                   gq[0] += 128; gq[1] += 128; gq[2] += 128; gq[3] += 128; }
            __builtin_amdgcn_sched_barrier(0);
        }
    }
}
__device__ __forceinline__ void down_phase(Frame& F, int p0, int np) {
    const int tid_ = opaque_tid(), lane = tid_ & 63, w = __builtin_amdgcn_readfirstlane(tid_ >> 6), r32 = lane & 31, hi = lane >> 5;
    const unsigned char* H = F.ws + WS_H; const char* WD = (const char*)(F.ws + WS_WD);
    const int* panel_e = (const int*)(F.ws + WS_PANEL); const unsigned long long* row_ptr = (const unsigned long long*)(F.ws + WS_ROWPTR); const float* row_w = (const float*)(F.ws + WS_ROWW);
    LAS unsigned char* lds = F.lds;
    LAS unsigned char* stg = lds + DN_STG + w * DN_STG_WAVE;
    LAS unsigned char* stg_t0 = stg + r32 * DN_STG_ROW + 16 * hi;
    const unsigned stg_ra = (unsigned)(size_t)(stg + (lane >> 3) * DN_STG_ROW + (lane & 7) * 16);
    unsigned dsrc[2];
#pragma unroll
    for (int j = 0; j < 2; ++j) { const int sg = 8 * w + 4 * j + (lane >> 4), su = lane & 15, u = su ^ (sg & 15); dsrc[j] = (unsigned)((32 * (sg >> 5) + dn_colperm(sg & 31)) * 256 + u * 16); }
    unsigned a[8];
#pragma unroll
    for (int f = 0; f < 8; ++f) a[f] = (unsigned)(size_t)lds + (unsigned)(DN_RING + r32 * 256 + (((4 * (f >> 1) + 2 * hi + (f & 1)) ^ (r32 & 15)) * 16));
    int p = p0 + F.vcu;
    if (p < p0 + np) {
        int rs = 0;
        const char* Wb = WD + (size_t)__builtin_amdgcn_readfirstlane(panel_e[p]) * (DM * EDIM);
        asm volatile("" ::: "memory"); __builtin_amdgcn_sched_barrier(0);
#pragma unroll
        for (int c = 0; c < DN_NSLOT; ++c)
#pragma unroll
            for (int j = 0; j < 2; ++j) __builtin_amdgcn_global_load_lds((const unsigned*)(Wb + (size_t)c * DN_SLOT + dsrc[j]), (LAS unsigned*)(lds + DN_RING + c * DN_SLOT + (2 * w + j) * 1024), 16, 0, 0);
        __builtin_amdgcn_sched_barrier(0);
        asm volatile("s_waitcnt vmcnt(10)" ::: "memory");
        __builtin_amdgcn_s_barrier(); asm volatile("" ::: "memory");
        u32x4 W[8];
#pragma unroll
        for (int f = 0; f < 8; ++f) DN_LDSRD(W[f], a[f], 0);
        for (;;) {
            const int pn = p + F.G; const bool more = pn < p0 + np;
            const char* Wbn = WD + (size_t)__builtin_amdgcn_readfirstlane(panel_e[more ? pn : p]) * (DM * EDIM);
            const int row0 = p * 256 + 32 * w;
            u32x8 hq[4];
            { const unsigned char* hrow = H + (size_t)(row0 + r32) * EDIM + hi * 32;
#pragma unroll
                for (int t = 0; t < 4; ++t) hq[t] = *(const u32x8*)(hrow + 64 * t); }
            GAS char* gq[4]; bool ok[4];
#pragma unroll
            for (int k = 0; k < 4; ++k) { GAS char* rp = (GAS char*)row_ptr[row0 + 8 * k + (lane >> 3)]; ok[k] = (size_t)((const unsigned char*)rp - (F.ws + WS_DUMP)) >= (size_t)(2 * MiB); gq[k] = rp + (lane & 7) * 16; }
            const float rw = row_w[row0 + r32] * (1.f / (H_SCALE * WD_SCALE));
            f32x16 accA, accB;
#pragma unroll
            for (int q = 0; q < 16; ++q) { accA[q] = 0.f; accB[q] = 0.f; }
#define DN_NSRC(c) ((c) + DN_NSLOT < 16 ? Wb + (size_t)((c) + DN_NSLOT) * DN_SLOT : Wbn + (size_t)((c) + DN_NSLOT - 16) * DN_SLOT)
            dn_chunk<true, 0, false>(DN_NSRC(0), accA, accB, W, hq, lds, a, rs, rw, stg_t0, stg_ra, gq, ok, dsrc, w);
#pragma unroll 1
            for (int c = 1; c < 15; c += 2) {
                dn_chunk<false, 1, false>(DN_NSRC(c), accA, accB, W, hq, lds, a, rs, rw, stg_t0, stg_ra, gq, ok, dsrc, w);
                if (c == 9)
                    __builtin_amdgcn_global_load_lds((const unsigned*)(H + (size_t)((more ? pn : p) * 256 + 32 * w) * EDIM + lane * 128), (LAS unsigned*)(lds + DN_TOUCH + w * 256), 4, 0, 0);
                dn_chunk<false, 0, true>(DN_NSRC(c + 1), accA, accB, W, hq, lds, a, rs, rw, stg_t0, stg_ra, gq, ok, dsrc, w);
            }
            dn_chunk<false, 1, false>(DN_NSRC(15), accA, accB, W, hq, lds, a, rs, rw, stg_t0, stg_ra, gq, ok, dsrc, w);
#undef DN_NSRC
            { u32x4 o;
                { int w0 = 0, w1 = 0, w2 = 0, w3 = 0;
                  w0 = __builtin_amdgcn_cvt_pk_fp8_f32(accB[0] * rw, accB[1] * rw, w0, false); w0 = __builtin_amdgcn_cvt_pk_fp8_f32(accB[2] * rw, accB[3] * rw, w0, true);
                  w1 = __builtin_amdgcn_cvt_pk_fp8_f32(accB[4] * rw, accB[5] * rw, w1, false); w1 = __builtin_amdgcn_cvt_pk_fp8_f32(accB[6] * rw, accB[7] * rw, w1, true);
                  w2 = __builtin_amdgcn_cvt_pk_fp8_f32(accB[8] * rw, accB[9] * rw, w2, false); w2 = __builtin_amdgcn_cvt_pk_fp8_f32(accB[10] * rw, accB[11] * rw, w2, true);
                  w3 = __builtin_amdgcn_cvt_pk_fp8_f32(accB[12] * rw, accB[13] * rw, w3, false); w3 = __builtin_amdgcn_cvt_pk_fp8_f32(accB[14] * rw, accB[15] * rw, w3, true);
                  o.x = (unsigned)w0; o.y = (unsigned)w1; o.z = (unsigned)w2; o.w = (unsigned)w3; }
                *(LAS u32x4*)(stg_t0 + 64 + 32) = o;
                u32x4 v0, v1, v2, v3; asm volatile("s_waitcnt lgkmcnt(0)" ::: "memory"); DN_LDSRD(v0, stg_ra, 0); DN_LDSRD(v1, stg_ra, 8 * DN_STG_ROW); DN_LDSRD(v2, stg_ra, 16 * DN_STG_ROW); DN_LDSRD(v3, stg_ra, 24 * DN_STG_ROW);
                asm volatile("s_waitcnt lgkmcnt(0)" : "+v"(v0), "+v"(v1), "+v"(v2), "+v"(v3));
                if (ok[0]) *(GAS u32x4*)gq[0] = v0; if (ok[1]) *(GAS u32x4*)gq[1] = v1; if (ok[2]) *(GAS u32x4*)gq[2] = v2; if (ok[3]) *(GAS u32x4*)gq[3] = v3; }
            if (!more) break;
            p = pn; Wb = Wbn;
        }
    }
    asm volatile("s_waitcnt vmcnt(0) lgkmcnt(0)" ::: "memory");
    __builtin_amdgcn_s_barrier(); asm volatile("" ::: "memory");
}
#undef DN_MFMA
#undef DN_DRAIN
#undef DN_LDSRD

__device__ __forceinline__ void combine_phase(Frame& F) {
    const int tid_ = opaque_tid(), lane_ = tid_ & 63, wave_ = __builtin_amdgcn_readfirstlane(tid_ >> 6);
    const bf16_t* x1 = (const bf16_t*)(F.ws + WS_XB);
    const int gw = F.vcu * NWAVES + wave_, NGW = F.G * NWAVES, lane = lane_;
    f32x4 g[4], bb[4];
#pragma unroll
    for (int j = 0; j < 4; ++j) { g[j] = *(const f32x4*)(F.ln2_g + lane * 16 + 4 * j); bb[j] = *(const f32x4*)(F.ln2_b + lane * 16 + 4 * j); }
    for (int t = gw; t < NTOK; t += NGW) {
        float v[16];
        { const u32x4* xr = (const u32x4*)(x1 + (size_t)t * DM) + 2 * lane; const u32x4 a = __builtin_nontemporal_load(xr), b = __builtin_nontemporal_load(xr + 1);
            v[0] = ALPHA * bflo(a.x); v[1] = ALPHA * bfhi(a.x); v[2] = ALPHA * bflo(a.y); v[3] = ALPHA * bfhi(a.y); v[4] = ALPHA * bflo(a.z); v[5] = ALPHA * bfhi(a.z); v[6] = ALPHA * bflo(a.w); v[7] = ALPHA * bfhi(a.w);
            v[8] = ALPHA * bflo(b.x); v[9] = ALPHA * bfhi(b.x); v[10] = ALPHA * bflo(b.y); v[11] = ALPHA * bfhi(b.y); v[12] = ALPHA * bflo(b.z); v[13] = ALPHA * bfhi(b.z); v[14] = ALPHA * bflo(b.w); v[15] = ALPHA * bfhi(b.w); }
        float f[16];
#pragma unroll
        for (int i = 0; i < 16; ++i) f[i] = 0.f;
#pragma unroll
        for (int s = 0; s < 9; ++s) { const u32x4 q = __builtin_nontemporal_load((const u32x4*)slot_addr(F.ws, F.out, s, t) + lane);
            const unsigned wv[4] = {q.x, q.y, q.z, q.w};
#pragma unroll
            for (int j = 0; j < 4; ++j) { const f32x2_t lo = __builtin_amdgcn_cvt_pk_f32_fp8((int)wv[j], false), hi2 = __builtin_amdgcn_cvt_pk_f32_fp8((int)wv[j], true);
                f[4 * j] += lo.x; f[4 * j + 1] += lo.y; f[4 * j + 2] += hi2.x; f[4 * j + 3] += hi2.y; } }
        float s = 0.f;
#pragma unroll
        for (int i = 0; i < 16; ++i) { v[i] += f[i] * SLOT_INV; s += v[i]; }
        const float mean = wave_sum(s) * (1.f / DM); float s2 = 0.f;
#pragma unroll
        for (int i = 0; i < 16; ++i) { v[i] -= mean; s2 += v[i] * v[i]; }
        const float rstd = 1.f / sqrtf(wave_sum(s2) * (1.f / DM) + LN_EPS);
        float* orow = F.out + (size_t)t * DM + lane * 16;
#pragma unroll
        for (int j = 0; j < 4; ++j) { f32x4 y; y.x = v[4 * j] * rstd; y.y = v[4 * j + 1] * rstd; y.z = v[4 * j + 2] * rstd; y.w = v[4 * j + 3] * rstd;
            *(f32x4*)(orow + 4 * j) = y * g[j] + bb[j]; }
    }
}

struct Args { const float* in[17]; float* out; unsigned char* ws; };
__global__ void __launch_bounds__(NWAVES * 64, 2) fwd_kernel(Args args) {
    extern __shared__ __attribute__((aligned(16))) unsigned char lds[];
    Frame F;
    F.lds = (LAS unsigned char*)lds;
    F.G = gridDim.x; { const int bx = blockIdx.x; F.vcu = (F.G % 8 == 0) ? (bx % 8) * (F.G / 8) + bx / 8 : bx; }
    F.ws = args.ws; F.out = args.out; F.ctl = (unsigned*)(args.ws + WS_CTL);
    F.x = args.in[0]; F.w_in = args.in[1]; F.conv_w = args.in[2]; F.w_o = args.in[3]; F.ln1_g = args.in[4]; F.ln1_b = args.in[5]; F.rel_bias = args.in[6]; F.w_router = args.in[7]; F.router_bias = args.in[8];
    F.eg = args.in[9]; F.eu = args.in[10]; F.ed = args.in[11]; F.sg = args.in[12]; F.su = args.in[13]; F.sd = args.in[14]; F.ln2_g = args.in[15]; F.ln2_b = args.in[16];
    volatile LAS unsigned* MISC = (volatile LAS unsigned*)(F.lds + MISC_OFF);
    for (int u = threadIdx.x; u < (LDS_BYTES - MISC_OFF) / 4; u += NWAVES * 64) MISC[u] = 0u;
    __syncthreads();
    XcdBarrier bar = xcd_barrier_post(F.ctl + CW_BAR, MISC + 8);
    LAS unsigned char* ring = F.lds;

    p0_prologue(F);
    xcd_barrier(bar);
    { DenseOrder S; S.init(NTOK, PROJW, DM / 2, F.G, (int)blockIdx.x, F.ws + WS_WIN); EpiProj E{(bf16_t*)(F.ws + WS_PROJ), (bf16_t*)(F.ws + WS_CONVIN)};
        pg8::gemm_phase<EpiProj, DenseOrder, true, true>(ring, (const char*)(F.ws + WS_XB), DM / 2, S, E); }
    xcd_barrier(bar);
    if (F.G == 256) {
        constexpr int ATT_GPR = 6;
        unsigned* tctr = F.ctl + CW_TEAM + (F.vcu >> 3) * 64; unsigned tgt = 0;
        for (int r0 = 0; r0 < 12; r0 += ATT_GPR) {
            for (int gi = 0; gi < ATT_GPR; ++gi) attn_pair<0>(F, F.vcu + (r0 + gi) * 256);
            tgt += 8; team_barrier(tctr, tgt);
            for (int gi = 0; gi < ATT_GPR; ++gi) attn_pair<1>(F, F.vcu + (r0 + gi) * 256);
            tgt += 8; team_barrier(tctr, tgt);
            for (int gi = 0; gi < ATT_GPR; ++gi) attn_pair<2>(F, F.vcu + (r0 + gi) * 256);
        }
        conv_phase(F);
        xcd_barrier(bar);
    } else {
        { attn_branch<0>(F); conv_phase(F); }
        xcd_barrier(bar);
        attn_branch<1>(F);
        xcd_barrier(bar);
        attn_branch<2>(F);
        xcd_barrier(bar);
    }
    { DenseOrder S; S.init(NTOK, DM, DM, F.G, (int)blockIdx.x, F.ws + WS_WO); EpiWo E{(bf16_t*)F.out, F.x};
        pg8::gemm_phase<EpiWo, DenseOrder, true>(ring, (const char*)(F.ws + WS_XB), DM, S, E); }
    xcd_barrier(bar);
    ln1_phase(F);
    xcd_barrier(bar);
    { DenseOrder S; S.init(NTOK, NEXP, DM, F.G, (int)blockIdx.x, F.ws + WS_WR); EpiF32 E{(float*)(F.ws + WS_LOGIT), NEXP};
        pg8::gemm_phase<EpiF32, DenseOrder, true>(ring, (const char*)(F.ws + WS_XB), DM, S, E); }
    xcd_barrier(bar);
    route_phase(F);
    xcd_barrier(bar);
    lists_phase(F);
    xcd_barrier(bar);
    const int PT = (int)__hip_atomic_load(F.ctl + CW_PT, __ATOMIC_RELAXED, __HIP_MEMORY_SCOPE_AGENT);
    { MoeOrder S{PT * 2, F.G, F.vcu, 1, 0, DM / 2, (const int*)(F.ws + WS_PANEL), (const int*)(F.ws + WS_ROWSRC), (const char*)(F.ws + WS_W13), (size_t)512 * DM};
        EpiGU E{(unsigned char*)(F.ws + WS_H)};
        pg8::gemm_phase<EpiGU, MoeOrder, true, true>(ring, (const char*)(F.ws + WS_X8), DM / 2, S, E); }
    xcd_barrier(bar);
    down_phase(F, 0, PT);
    xcd_barrier(bar);
    combine_phase(F);
}

extern "C" void kernel_launch(void* const* d_in, const int* in_sizes, int n_in, void* d_out, int out_size, void* d_ws, size_t ws_size, hipStream_t stream) {
    static int grid = 0;
    if (grid == 0) {
        if (n_in != 17 || out_size != NTOK * DM || ws_size < WS_NEED) { fprintf(stderr, "kernel_launch: unexpected problem (n_in %d, out %d, ws %zu)\n", n_in, out_size, ws_size); grid = -1; return; }
        int dev = 0, cus = 0;
        if (hipGetDevice(&dev) != hipSuccess || hipDeviceGetAttribute(&cus, hipDeviceAttributeMultiprocessorCount, dev) != hipSuccess) { grid = -1; return; }
        if (hipFuncSetAttribute((const void*)fwd_kernel, hipFuncAttributeMaxDynamicSharedMemorySize, LDS_BYTES) != hipSuccess) { fprintf(stderr, "kernel_launch: hipFuncSetAttribute failed\n"); grid = -1; return; }
        int per_cu = 0;
        if (hipOccupancyMaxActiveBlocksPerMultiprocessor(&per_cu, (const void*)fwd_kernel, NWAVES * 64, LDS_BYTES) != hipSuccess || per_cu < 1) { fprintf(stderr, "kernel_launch: occupancy query reports %d\n", per_cu); }
        (void)hipGetLastError();
        grid = cus;
    }
    if (grid < 0) return;
    (void)hipMemsetAsync((char*)d_ws + WS_CTL, 0, CTL_ZERO_BYTES, stream);
    Args a{};
    for (int i = 0; i < 17; ++i) a.in[i] = (const float*)d_in[i];
    a.out = (float*)d_out; a.ws = (unsigned char*)d_ws;
    hipLaunchKernelGGL(fwd_kernel, dim3(grid), dim3(NWAVES * 64), LDS_BYTES, stream, a);
}
```
